# Optimizing an MI355X kernel written in HIP

```python
import jax, jax.numpy as jnp
from jax import lax
import numpy as np

D_MODEL = 1024
BATCH = 2
SEQ = 16384
DEPTH = 1

N_MLSTM_HEADS = 4
MLSTM_WIDTH = D_MODEL // 2
V_HEAD_DIM = MLSTM_WIDTH // N_MLSTM_HEADS
QK_HEAD_DIM = V_HEAD_DIM // 2
QK_WIDTH = N_MLSTM_HEADS * QK_HEAD_DIM
N_GATES = 4 * N_MLSTM_HEADS
CHUNK = 128
N_FOURIER_GROUPS = 4
FOURIER_WIDTH = D_MODEL - MLSTM_WIDTH
FOURIER_GROUP_DIM = FOURIER_WIDTH // N_FOURIER_GROUPS
MIX_WIDTH = MLSTM_WIDTH + FOURIER_WIDTH
IN_SPLITS = [QK_WIDTH, QK_WIDTH, MLSTM_WIDTH, MLSTM_WIDTH, FOURIER_WIDTH, N_GATES]
IN_COLS = sum(IN_SPLITS)
D_FF = 4 * D_MODEL
N_MOD = 6
ALPHA = (2 * DEPTH) ** 0.25
BETA = (8 * DEPTH) ** -0.25
LN_EPS = 1e-5

kernel_name = "hybrid_mlstm_fnet_deepnorm_adaln_block"


def _ln_plain(x):
    xf = x.astype(jnp.float32)
    mu = xf.mean(-1, keepdims=True)
    var = jnp.square(xf - mu).mean(-1, keepdims=True)
    return ((xf - mu) * lax.rsqrt(var + LN_EPS)).astype(x.dtype)


def _ln_affine(x, g, b):
    xf = x.astype(jnp.float32)
    mu = xf.mean(-1, keepdims=True)
    var = jnp.square(xf - mu).mean(-1, keepdims=True)
    y = (xf - mu) * lax.rsqrt(var + LN_EPS) * g.astype(jnp.float32) + b.astype(jnp.float32)
    return y.astype(x.dtype)


def _mlstm_chunkwise(q, k, v, log_i, log_f):
    B, H, S, dk = q.shape
    dv = v.shape[-1]
    nc = S // CHUNK

    def to_chunks(a):
        return jnp.moveaxis(a.reshape((B, H, nc, CHUNK) + a.shape[3:]), 2, 0)

    xs = tuple(to_chunks(a) for a in (q, k, v, log_i, log_f))
    lower = jnp.tril(jnp.ones((CHUNK, CHUNK), dtype=bool))

    def step(carry, blk):
        C, n, m = carry
        qb, kb, vb, ib, fb = blk
        b = jnp.cumsum(fb, axis=-1)
        D = jnp.where(lower, b[..., :, None] - b[..., None, :] + ib[..., None, :], -jnp.inf)
        inter = b + m[..., None]
        m_t = jnp.maximum(inter, D.max(-1))
        w_intra = jnp.exp(D - m_t[..., None])
        w_inter = jnp.exp(inter - m_t)
        s = jnp.einsum('bhtd,bhsd->bhts', qb, kb) * w_intra
        num = jnp.einsum('bhts,bhsv->bhtv', s, vb) + w_inter[..., None] * jnp.einsum('bhtd,bhdv->bhtv', qb, C)
        den = s.sum(-1) + w_inter * jnp.einsum('bhtd,bhd->bht', qb, n)
        h = num / jnp.maximum(jnp.abs(den), jnp.exp(-m_t))[..., None]
        bL = b[..., -1]
        g = bL[..., None] - b + ib
        m_new = jnp.maximum(bL + m, g.max(-1))
        wk = jnp.exp(g - m_new[..., None])
        decay = jnp.exp(bL + m - m_new)
        C_new = decay[..., None, None] * C + jnp.einsum('bhs,bhsd,bhsv->bhdv', wk, kb, vb)
        n_new = decay[..., None] * n + jnp.einsum('bhs,bhsd->bhd', wk, kb)
        return (C_new, n_new, m_new), h

    init = (jnp.zeros((B, H, dk, dv), jnp.float32), jnp.zeros((B, H, dk), jnp.float32),
            jnp.zeros((B, H), jnp.float32))
    _, hs = lax.scan(step, init, xs)
    return jnp.moveaxis(hs, 0, 2).reshape(B, H, S, dv)


def _mlstm_group(q, k, v, o, gates, b_gate, norm_w):
    B, S, _ = q.shape
    H = N_MLSTM_HEADS
    f32 = jnp.float32
    qh = q.astype(f32).reshape(B, S, H, QK_HEAD_DIM).transpose(0, 2, 1, 3) * (QK_HEAD_DIM ** -0.5)
    kh = k.astype(f32).reshape(B, S, H, QK_HEAD_DIM).transpose(0, 2, 1, 3)
    vh = v.astype(f32).reshape(B, S, H, V_HEAD_DIM).transpose(0, 2, 1, 3)
    gt = (gates.astype(f32) + b_gate.astype(f32)).reshape(B, S, 4, H).transpose(2, 0, 3, 1)
    log_i_f, log_f_f = gt[0], jax.nn.log_sigmoid(gt[1])
    log_i_b, log_f_b = gt[2], jax.nn.log_sigmoid(gt[3])
    h_fwd = _mlstm_chunkwise(qh, kh, vh, log_i_f, log_f_f)
    rev = lambda a: jnp.flip(a, axis=2)
    h_bwd = rev(_mlstm_chunkwise(rev(qh), rev(kh), rev(vh), rev(log_i_b), rev(log_f_b)))
    h = h_fwd + h_bwd
    mu = h.mean(-1, keepdims=True)
    var = jnp.square(h - mu).mean(-1, keepdims=True)
    h = (h - mu) * lax.rsqrt(var + LN_EPS) * norm_w.astype(f32).reshape(H, 1, V_HEAD_DIM)
    h = h.transpose(0, 2, 1, 3).reshape(B, S, MLSTM_WIDTH)
    return (h * jax.nn.sigmoid(o.astype(f32))).astype(q.dtype)


def _fourier_group(z):
    B, S, _ = z.shape
    zg = z.astype(jnp.float32).reshape(B, S, N_FOURIER_GROUPS, FOURIER_GROUP_DIM)
    y = jnp.fft.fft2(zg, axes=(1, 3), norm='ortho').real
    return y.reshape(B, S, FOURIER_WIDTH).astype(z.dtype)


def _layer(x, c_act, w_ada, b_ada, w_in, b_gate, mlstm_norm_w, w_out, ln1_g, ln1_b,
           w_ff1, b_ff1, w_ff2, b_ff2, ln2_g, ln2_b):
    mod = (c_act @ w_ada + b_ada)[:, None, :]
    sh1, sc1, g1, sh2, sc2, g2 = jnp.split(mod, N_MOD, axis=-1)
    h = _ln_plain(x) * (1 + sc1) + sh1
    proj = h @ w_in
    q, k, v, o, fz, gates = jnp.split(proj, np.cumsum(IN_SPLITS)[:-1].tolist(), axis=-1)
    y_mlstm = _mlstm_group(q, k, v, o, gates, b_gate, mlstm_norm_w)
    y_fourier = _fourier_group(fz)
    mix = jnp.concatenate([y_mlstm, y_fourier], axis=-1) @ w_out
    x = _ln_affine(ALPHA * x + (1 + g1) * mix, ln1_g, ln1_b)
    h2 = _ln_plain(x) * (1 + sc2) + sh2
    ff = jnp.square(jax.nn.relu(h2 @ w_ff1 + b_ff1)) @ w_ff2 + b_ff2
    return _ln_affine(ALPHA * x + (1 + g2) * ff, ln2_g, ln2_b)


def setup_inputs(seed: int = 0) -> dict:
    key = jax.random.key(seed)
    ks = jax.random.split(key, 20)
    f32 = jnp.float32
    nrm = lambda k, shape, s: jax.random.normal(k, shape, f32) * s
    f_bias = jnp.linspace(3.0, 6.0, N_MLSTM_HEADS, dtype=f32)
    gate_base = jnp.concatenate([jnp.zeros((N_MLSTM_HEADS,), f32), f_bias,
                                 jnp.zeros((N_MLSTM_HEADS,), f32), f_bias])
    return {
        "x": nrm(ks[0], (BATCH, SEQ, D_MODEL), 1.0),
        "c": nrm(ks[1], (BATCH, D_MODEL), 1.0),
        "w_ada": nrm(ks[2], (DEPTH, D_MODEL, N_MOD * D_MODEL), 0.1 * D_MODEL ** -0.5),
        "b_ada": nrm(ks[3], (DEPTH, N_MOD * D_MODEL), 0.01),
        "w_in": nrm(ks[4], (DEPTH, D_MODEL, IN_COLS), D_MODEL ** -0.5),
        "b_gate": gate_base[None, :] + nrm(ks[5], (DEPTH, N_GATES), 0.1),
        "mlstm_norm_w": 1.0 + nrm(ks[6], (DEPTH, MLSTM_WIDTH), 0.02),
        "w_out": nrm(ks[7], (DEPTH, MIX_WIDTH, D_MODEL), BETA * MIX_WIDTH ** -0.5),
        "ln1_g": 1.0 + nrm(ks[8], (DEPTH, D_MODEL), 0.02),
        "ln1_b": nrm(ks[9], (DEPTH, D_MODEL), 0.02),
        "w_ff1": nrm(ks[10], (DEPTH, D_MODEL, D_FF), D_MODEL ** -0.5),
        "b_ff1": nrm(ks[11], (DEPTH, D_FF), 0.02),
        "w_ff2": nrm(ks[12], (DEPTH, D_FF, D_MODEL), BETA * D_FF ** -0.5),
        "b_ff2": nrm(ks[13], (DEPTH, D_MODEL), 0.02),
        "ln2_g": 1.0 + nrm(ks[14], (DEPTH, D_MODEL), 0.02),
        "ln2_b": nrm(ks[15], (DEPTH, D_MODEL), 0.02),
    }


def reference(x, c, w_ada, b_ada, w_in, b_gate, mlstm_norm_w, w_out, ln1_g, ln1_b,
              w_ff1, b_ff1, w_ff2, b_ff2, ln2_g, ln2_b):
    c_act = jax.nn.silu(c)
    for l in range(DEPTH):
        x = _layer(x, c_act, w_ada[l], b_ada[l], w_in[l], b_gate[l], mlstm_norm_w[l], w_out[l],
                   ln1_g[l], ln1_b[l], w_ff1[l], b_ff1[l], w_ff2[l], b_ff2[l], ln2_g[l], ln2_b[l])
    return x
```

```cpp
#include <hip/hip_runtime.h>
#include <hip/hip_cooperative_groups.h>
#include <cstdio>
#include <cstdint>
namespace cg = cooperative_groups;

#define LAS __attribute__((address_space(3)))
typedef unsigned short bf16_t;
typedef short bf16x8 __attribute__((ext_vector_type(8)));
typedef short bf16x4 __attribute__((ext_vector_type(4)));
typedef float f32x4 __attribute__((ext_vector_type(4)));
typedef float f32x2 __attribute__((ext_vector_type(2)));
typedef unsigned u32x4 __attribute__((ext_vector_type(4)));
typedef unsigned u32x2 __attribute__((ext_vector_type(2)));

constexpr int NB = 2, SEQ = 16384, DM = 1024, MT = NB * SEQ, FF = 4096, NH = 4;
constexpr int NCHUNK = 128;
constexpr int NCAT = 2304;
constexpr int KOUT = 1536;
constexpr float LN_EPS = 1e-5f;
constexpr float ALPHA = 1.189207115002721f;
constexpr int ST_ROW = 129 * 64;

constexpr size_t KiB = 1024, MiB = 1u << 20;
constexpr size_t WS_MOD = 0, WS_TW = 64 * KiB, WS_ST1 = 192 * KiB, WS_MIN = 448 * KiB, WS_SC = 456 * KiB, WS_B1 = 512 * KiB, WS_B2 = 576 * KiB;
constexpr size_t WS_WCAT = 1 * MiB, WS_WOUT = 6 * MiB, WS_W1 = 9 * MiB, WS_W2 = 17 * MiB;
constexpr size_t WS_H = 32 * MiB;
constexpr size_t WS_QK = 96 * MiB, WS_V = 128 * MiB, WS_O = 160 * MiB, WS_GATES = 192 * MiB, WS_FZ = 194 * MiB, WS_F1O = 226 * MiB, WS_AOUT = 290 * MiB,
                 WS_KVL = 386 * MiB, WS_CST = 452 * MiB, WS_END = 486 * MiB;
constexpr size_t WS_HID = 96 * MiB;
constexpr int LDS_BYTES = 147456;

__device__ __forceinline__ unsigned f2bf(float f) { unsigned u = __builtin_bit_cast(unsigned, f); return (u + 0x7fffu + ((u >> 16) & 1u)) >> 16; }
__device__ __forceinline__ unsigned pk2(float lo, float hi) { return f2bf(lo) | (f2bf(hi) << 16); }
__device__ __forceinline__ float bf2f(unsigned short h) { return __builtin_bit_cast(float, (unsigned)h << 16); }
__device__ __forceinline__ float wave_sum(float v) {
#pragma unroll
    for (int o = 1; o < 64; o <<= 1) v += __shfl_xor(v, o);
    return v;
}
__device__ __forceinline__ float log_sigmoid(float x) { return fminf(x, 0.f) - __logf(1.0f + __expf(-fabsf(x))); }

namespace pg8 {
constexpr int BM = 256, BK = 64, HALF = 128, HTB = HALF * BK * 2, STAGE_BYTES = 8 * HTB, NXCD = 8, WGM = 8;
__host__ __device__ __forceinline__ int lds_byte(int r, int c) { const int st = (r >> 4) * 2 + (c >> 5), rr = r & 15, cc = c & 31, ob = rr * 64 + cc * 2; return st * 1024 + (ob ^ (((ob >> 9) & 1) << 5)); }
__host__ __device__ __forceinline__ void stage_rc(int b, int& R, int& C) { const int st = b / 1024, sb = b % 1024, swz = sb ^ (((sb >> 9) & 1) << 5); R = (st >> 1) * 16 + swz / 64; C = (st & 1) * 32 + (swz % 64) / 2; }
__host__ __device__ __forceinline__ int perm32(int rho) { const int n = rho >> 4, i = rho & 15; return 8 * (i >> 2) + 4 * n + (i & 3); }

struct Unit { int pm, pn; };
struct Gemm { const bf16_t* A; const bf16_t* Bt; int M, N, K; unsigned lda; size_t hstep; int tdiv; size_t thi, tlo; };
__device__ __forceinline__ Gemm std_gemm(const bf16_t* A, const bf16_t* Bt, int M, int N, int K) {
    Gemm g; g.A = A; g.Bt = Bt; g.M = M; g.N = N; g.K = K; g.lda = (unsigned)K * 2u; g.hstep = (size_t)HALF * K * 2; g.tdiv = 1 << 30; g.thi = 0; g.tlo = (size_t)BM * K * 2; return g;
}

struct StaticOrder {
    int nM, nN, nwg, G, c;
    __device__ void init(int M, int N, int G_, int c_) { nM = M / BM; nN = N / BM; nwg = nM * nN; G = G_; c = c_; }
    __device__ bool next(int i, Unit& u) const {
        const long L = (long)i * G + c; if (L >= nwg) return false;
        int wgid = (int)L; { const int q = nwg / NXCD, r = nwg % NXCD, xcd = wgid % NXCD, off = wgid / NXCD; wgid = (xcd < r ? xcd * (q + 1) : r * (q + 1) + (xcd - r) * q) + off; }
        const int nig = WGM * nN, gid = wgid / nig, fm = gid * WGM, gsz = (nM - fm) < WGM ? (nM - fm) : WGM;
        u.pm = fm + ((wgid % nig) % gsz); u.pn = (wgid % nig) / gsz; return true;
    }
};

__device__ __forceinline__ unsigned cvt_pk_bf16(float lo, float hi) { unsigned r; asm volatile("v_cvt_pk_bf16_f32 %0, %1, %2" : "=v"(r) : "v"(lo), "v"(hi)); return r; }

template <class Epi, bool SWAP>
__device__ __forceinline__ void gemm_phase(LAS unsigned char* lds, const Gemm g, const StaticOrder& S, const Epi& E) {
    int tid_ = threadIdx.x; asm volatile("" : "+v"(tid_));
    const int tid = tid_, wid = __builtin_amdgcn_readfirstlane(tid >> 6), lane = tid & 63, wr = wid >> 2, wc = wid & 3, fr = lane & 15, fq = lane >> 4;
    const int K = g.K, nt = K / BK;
    unsigned voffA[2], voffB[2];
#pragma unroll
    for (int i = 0; i < 2; ++i) { int R, C; stage_rc(tid * 16 + i * 8192, R, C); const int Rb = (Epi::PERM && !SWAP) ? ((R & ~31) + perm32(R & 31)) : R;
        voffA[i] = (unsigned)R * g.lda + (unsigned)C * 2u; voffB[i] = (unsigned)(Rb * K + C) * 2u; }
    const size_t kstep = (size_t)(BK * 2);
    const size_t hstepA = g.hstep;
    const size_t hstepB = (size_t)HALF * K * 2, tstepB = 2 * hstepB;
    const unsigned ldsw = (unsigned)wid * 1024u;
    const int aoff = lds_byte(wr * 64 + fr, fq * 8), boff = lds_byte(wc * 32 + fr, fq * 8);
#define PG8_SA(b, h) (((b) * 2 + (h)) * HTB)
#define PG8_SB(b, h) ((4 + (b) * 2 + (h)) * HTB)
#define PG8_ABASE(pm) ((const char*)g.A + (size_t)((pm) / g.tdiv) * g.thi + (size_t)((pm) % g.tdiv) * g.tlo)
#define PG8_STAGE(bufoff, gbase, voff) do { _Pragma("unroll") for (int _i = 0; _i < 2; ++_i) \
        __builtin_amdgcn_global_load_lds((const unsigned*)((const char*)(gbase) + (voff)[_i]), (LAS unsigned*)(lds + (bufoff) + ldsw + _i * 8192), 16, 0, 0); } while (0)
#define PG8_LDA(dst, b, h) do { _Pragma("unroll") for (int m = 0; m < 4; ++m) _Pragma("unroll") for (int k = 0; k < 2; ++k) dst[m][k] = *(const LAS bf16x8*)(lds + PG8_SA(b, h) + aoff + m * 2048 + k * 1024); } while (0)
#define PG8_LDB(dst, b, h) do { _Pragma("unroll") for (int n = 0; n < 2; ++n) _Pragma("unroll") for (int k = 0; k < 2; ++k) dst[n][k] = *(const LAS bf16x8*)(lds + PG8_SB(b, h) + boff + n * 2048 + k * 1024); } while (0)
#define PG8_MMA(ai, bj, At, Bt) do { __builtin_amdgcn_s_setprio(1); _Pragma("unroll") for (int m = 0; m < 4; ++m) _Pragma("unroll") for (int n = 0; n < 2; ++n) _Pragma("unroll") for (int k = 0; k < 2; ++k) \
        acc[ai][bj][m][n] = SWAP ? __builtin_amdgcn_mfma_f32_16x16x32_bf16(At[m][k], Bt[n][k], acc[ai][bj][m][n], 0, 0, 0) \
                                 : __builtin_amdgcn_mfma_f32_16x16x32_bf16(Bt[n][k], At[m][k], acc[ai][bj][m][n], 0, 0, 0); __builtin_amdgcn_s_setprio(0); } while (0)
#define PG8_WAIT_V(n) asm volatile("s_waitcnt vmcnt(" #n ")" ::: "memory")
#define PG8_WAIT_L(n) asm volatile("s_waitcnt lgkmcnt(" #n ")" ::: "memory")
#define PG8_BAR __builtin_amdgcn_s_barrier()
#define PG8_SCHED __builtin_amdgcn_sched_barrier(0)
    Unit cur, nxt; int ui = 0;
    if (!S.next(0, cur)) return;
    f32x4 acc[2][2][4][2];
#pragma unroll
    for (int a = 0; a < 2; ++a)
#pragma unroll
        for (int b = 0; b < 2; ++b)
#pragma unroll
            for (int m = 0; m < 4; ++m)
#pragma unroll
                for (int n = 0; n < 2; ++n) acc[a][b][m][n] = (f32x4){0.f, 0.f, 0.f, 0.f};
    bf16x8 At[4][2], B0[2][2], B1[2][2];
    const char* cA = PG8_ABASE(cur.pm); const char* cB = (const char*)g.Bt + (size_t)cur.pn * tstepB;
    PG8_STAGE(PG8_SB(0, 0), cB, voffB); PG8_STAGE(PG8_SB(0, 1), cB + hstepB, voffB); PG8_STAGE(PG8_SA(0, 0), cA, voffA); PG8_STAGE(PG8_SA(0, 1), cA + hstepA, voffA);
    if (wr == 1) PG8_BAR;
    PG8_WAIT_V(2); PG8_BAR;
    PG8_STAGE(PG8_SB(1, 0), cB + kstep, voffB); PG8_STAGE(PG8_SA(1, 0), cA + kstep, voffA); PG8_STAGE(PG8_SB(1, 1), cB + hstepB + kstep, voffB);
    PG8_WAIT_V(6); PG8_BAR;
    for (;;) {
        const bool has_next = S.next(ui + 1, nxt);
        const char* nA = has_next ? PG8_ABASE(nxt.pm) : cA; const char* nB = has_next ? (const char*)g.Bt + (size_t)nxt.pn * tstepB : cB;
        for (int t = 0; t < nt; t += 2) {
            const bool last = (t == nt - 2);
            const char* a1 = cA + (size_t)(t + 1) * kstep;
            const char* a2 = last ? nA : cA + (size_t)(t + 2) * kstep; const char* b2 = last ? nB : cB + (size_t)(t + 2) * kstep;
            const char* a3 = a2 + kstep; const char* b3 = b2 + kstep;
            PG8_LDB(B0, 0, 0); PG8_LDB(B1, 0, 1); PG8_SCHED; PG8_LDA(At, 0, 0); PG8_STAGE(PG8_SA(1, 1), a1 + hstepA, voffA);
            PG8_WAIT_V(8); PG8_WAIT_L(0); PG8_BAR; PG8_MMA(0, 0, At, B0); PG8_MMA(0, 1, At, B1); PG8_BAR; PG8_SCHED;
            PG8_LDA(At, 0, 1); PG8_STAGE(PG8_SB(0, 0), b2, voffB); PG8_STAGE(PG8_SB(0, 1), b2 + hstepB, voffB); PG8_STAGE(PG8_SA(0, 0), a2, voffA);
            PG8_WAIT_V(8); PG8_WAIT_L(0); PG8_BAR; PG8_MMA(1, 0, At, B0); PG8_MMA(1, 1, At, B1); PG8_BAR; PG8_SCHED;
            PG8_LDB(B0, 1, 0); PG8_LDB(B1, 1, 1); PG8_SCHED; PG8_LDA(At, 1, 0); PG8_STAGE(PG8_SA(0, 1), a2 + hstepA, voffA);
            PG8_WAIT_V(8); PG8_WAIT_L(0); PG8_BAR; PG8_MMA(0, 0, At, B0); PG8_MMA(0, 1, At, B1); PG8_BAR; PG8_SCHED;
            PG8_LDA(At, 1, 1); PG8_STAGE(PG8_SB(1, 0), b3, voffB); PG8_STAGE(PG8_SB(1, 1), b3 + hstepB, voffB); PG8_STAGE(PG8_SA(1, 0), a3, voffA);
            PG8_WAIT_V(8); PG8_WAIT_L(0); PG8_BAR; PG8_MMA(1, 0, At, B0); PG8_MMA(1, 1, At, B1); PG8_BAR; PG8_SCHED;
        }
        if (wr == 0) PG8_BAR;
        { int fr_e = fr, fq_e = fq; asm volatile("" : "+v"(fr_e), "+v"(fq_e));
          E(acc, cur, wr, wc, fr_e, fq_e); }
        if (!has_next) break;
#pragma unroll
        for (int a = 0; a < 2; ++a)
#pragma unroll
            for (int b = 0; b < 2; ++b)
#pragma unroll
                for (int m = 0; m < 4; ++m)
#pragma unroll
                    for (int n = 0; n < 2; ++n) acc[a][b][m][n] = (f32x4){0.f, 0.f, 0.f, 0.f};
        cur = nxt; cA = nA; cB = nB; ++ui;
        if (wr == 1) PG8_BAR;
    }
    PG8_WAIT_V(0);
    PG8_BAR;
#undef PG8_SA
#undef PG8_SB
#undef PG8_ABASE
#undef PG8_STAGE
#undef PG8_LDA
#undef PG8_LDB
#undef PG8_MMA
#undef PG8_WAIT_V
#undef PG8_WAIT_L
#undef PG8_BAR
#undef PG8_SCHED
}

typedef f32x4 AccT[2][2][4][2];

struct EpiMain {
    static constexpr bool PERM = true;
    bf16_t* QK; bf16_t* V; bf16_t* O; float* gates; const float* b_gate;
    __device__ __forceinline__ void operator()(const AccT& acc, const Unit& u, int wr, int wc, int fr, int fq) const {
        const int row0 = u.pm * BM + wr * 64 + fr;
        if (u.pn < 6) {
            bf16_t* base = QK + (size_t)(u.pn >> 1) * (size_t)(16u << 20) + (u.pn & 1) * 256 + wc * 32 + 8 * fq;
#pragma unroll
            for (int ai = 0; ai < 2; ++ai)
#pragma unroll
                for (int m = 0; m < 4; ++m) { bf16_t* rowp = base + (size_t)(row0 + ai * HALF + m * 16) * 512;
#pragma unroll
                    for (int bj = 0; bj < 2; ++bj) { const f32x4 v0 = acc[ai][bj][m][0], v1 = acc[ai][bj][m][1];
                        u32x4 w; w.x = cvt_pk_bf16(v0[0], v0[1]); w.y = cvt_pk_bf16(v0[2], v0[3]); w.z = cvt_pk_bf16(v1[0], v1[1]); w.w = cvt_pk_bf16(v1[2], v1[3]);
                        *(u32x4*)(rowp + bj * HALF) = w; } }
        } else if (wc == 0 && fq < 2) {
#pragma unroll
            for (int n = 0; n < 2; ++n) { const int col = 8 * fq + 4 * n; const f32x4 bg = *(const f32x4*)(b_gate + col); const bool isf = (n == 1);
#pragma unroll
                for (int ai = 0; ai < 2; ++ai)
#pragma unroll
                    for (int m = 0; m < 4; ++m) { f32x4 v = acc[ai][0][m][n] + bg;
                        if (isf) { v[0] = log_sigmoid(v[0]); v[1] = log_sigmoid(v[1]); v[2] = log_sigmoid(v[2]); v[3] = log_sigmoid(v[3]); }
                        *(f32x4*)(gates + (size_t)(row0 + ai * HALF + m * 16) * 16 + col) = v; } }
        }
    }
};
struct EpiFF1 {
    static constexpr bool PERM = true;
    bf16_t* Hd; const float* bias;
    __device__ __forceinline__ void operator()(const AccT& acc, const Unit& u, int wr, int wc, int fr, int fq) const {
        const int row0 = u.pm * BM + wr * 64 + fr, col0 = u.pn * BM + wc * 32 + 8 * fq;
        f32x4 bv[2][2];
#pragma unroll
        for (int bj = 0; bj < 2; ++bj)
#pragma unroll
            for (int n = 0; n < 2; ++n) bv[bj][n] = *(const f32x4*)(bias + col0 + bj * HALF + 4 * n);
#pragma unroll
        for (int ai = 0; ai < 2; ++ai)
#pragma unroll
            for (int m = 0; m < 4; ++m) { bf16_t* rowp = Hd + (size_t)(row0 + ai * HALF + m * 16) * FF + col0;
#pragma unroll
                for (int bj = 0; bj < 2; ++bj) { f32x4 v0 = acc[ai][bj][m][0] + bv[bj][0], v1 = acc[ai][bj][m][1] + bv[bj][1];
#pragma unroll
                    for (int j = 0; j < 4; ++j) { const float a = fmaxf(v0[j], 0.f), b = fmaxf(v1[j], 0.f); v0[j] = a * a; v1[j] = b * b; }
                    u32x4 w; w.x = cvt_pk_bf16(v0[0], v0[1]); w.y = cvt_pk_bf16(v0[2], v0[3]); w.z = cvt_pk_bf16(v1[0], v1[1]); w.w = cvt_pk_bf16(v1[2], v1[3]);
                    *(u32x4*)(rowp + bj * HALF) = w; } }
    }
};
struct EpiOut {
    static constexpr bool PERM = true;
    const float* x; float* U; const float* mod;
    __device__ __forceinline__ void operator()(const AccT& acc, const Unit& u, int wr, int wc, int fr, int fq) const {
        const int row0 = u.pm * BM + wr * 64 + fr, col0 = u.pn * BM + wc * 32 + 8 * fq;
        const float* g1 = mod + (size_t)((u.pm * BM) >> 14) * 6144 + 2048 + col0;
        f32x4 gv[2][2];
#pragma unroll
        for (int bj = 0; bj < 2; ++bj)
#pragma unroll
            for (int n = 0; n < 2; ++n) gv[bj][n] = *(const f32x4*)(g1 + bj * HALF + 4 * n) + 1.0f;
#pragma unroll
        for (int ai = 0; ai < 2; ++ai)
#pragma unroll
            for (int m = 0; m < 4; ++m) { const size_t off = (size_t)(row0 + ai * HALF + m * 16) * DM + col0;
#pragma unroll
                for (int bj = 0; bj < 2; ++bj)
#pragma unroll
                    for (int n = 0; n < 2; ++n) { const f32x4 xv = *(const f32x4*)(x + off + bj * HALF + 4 * n);
                        *(f32x4*)(U + off + bj * HALF + 4 * n) = xv * ALPHA + gv[bj][n] * acc[ai][bj][m][n]; } }
    }
};
struct EpiFF2 {
    static constexpr bool PERM = true;
    float* U; const float* mod; const f32x2* st1; const float* ln_g; const float* ln_b; const float* b2;
    __device__ __forceinline__ void operator()(const AccT& acc, const Unit& u, int wr, int wc, int fr, int fq) const {
        const int row0 = u.pm * BM + wr * 64 + fr, col0 = u.pn * BM + wc * 32 + 8 * fq;
        const float* g2 = mod + (size_t)((u.pm * BM) >> 14) * 6144 + 5120 + col0;
#pragma unroll
        for (int bj = 0; bj < 2; ++bj)
#pragma unroll
            for (int n = 0; n < 2; ++n) { const int c = col0 + bj * HALF + 4 * n;
                const f32x4 gv = *(const f32x4*)(g2 + bj * HALF + 4 * n) + 1.0f, lg = *(const f32x4*)(ln_g + c), lb = *(const f32x4*)(ln_b + c), bb = *(const f32x4*)(b2 + c);
#pragma unroll
                for (int ai = 0; ai < 2; ++ai)
#pragma unroll
                    for (int m = 0; m < 4; ++m) { const int r = row0 + ai * HALF + m * 16; const f32x2 s = st1[r]; float* p = U + (size_t)r * DM + c;
                        const f32x4 uv = *(const f32x4*)p; const f32x4 x1 = (uv - s.x) * s.y * lg + lb;
                        *(f32x4*)p = x1 * ALPHA + gv * (acc[ai][bj][m][n] + bb); } }
    }
};
struct EpiF0 {
    static constexpr bool PERM = false;
    bf16_t* FZ;
    __device__ __forceinline__ void operator()(const AccT& acc, const Unit& u, int wr, int wc, int fr, int fq) const {
        const int b = u.pm >> 6, s20 = (u.pm & 63) * 2;
#pragma unroll
        for (int bj = 0; bj < 2; ++bj)
#pragma unroll
            for (int n = 0; n < 2; ++n) { const int c = u.pn * BM + bj * HALF + wc * 32 + n * 16 + fr;
#pragma unroll
                for (int ai = 0; ai < 2; ++ai)
#pragma unroll
                    for (int m = 0; m < 4; ++m) { const f32x4 v = acc[ai][bj][m][n];
                        u32x2 w; w.x = cvt_pk_bf16(v[0], v[1]); w.y = cvt_pk_bf16(v[2], v[3]);
                        *(u32x2*)(FZ + ((size_t)(b * 512 + c) * 128 + s20 + ai) * 128 + wr * 64 + m * 16 + 4 * fq) = w; } }
    }
};
struct EpiF1 {
    static constexpr bool PERM = false;
    bf16_t* F1O; const f32x2* TW;
    __device__ __forceinline__ void operator()(const AccT& acc, const Unit& u, int wr, int wc, int fr, int fq) const {
#pragma unroll
        for (int n = 0; n < 2; ++n) { const int k1 = wc * 32 + n * 16 + fr;
            const f32x2 w16 = TW[(16 * k1) & 16383];
            f32x2 t[4];
#pragma unroll
            for (int j = 0; j < 4; ++j) t[j] = TW[((wr * 64 + 4 * fq + j) * k1) & 16383];
#pragma unroll
            for (int m = 0; m < 4; ++m) { const int s2 = wr * 64 + m * 16 + 4 * fq;
#pragma unroll
                for (int ai = 0; ai < 2; ++ai) { const int bc = u.pm * 2 + ai, b = bc >> 9, c = bc & 511;
                    bf16_t* dst = F1O + (((size_t)(b * 128 + k1) * 512 + c) * 2) * 128;
                    const f32x4 ar = acc[ai][0][m][n], ai_ = acc[ai][1][m][n];
                    float pr[4], pi[4];
#pragma unroll
                    for (int j = 0; j < 4; ++j) { pr[j] = ar[j] * t[j].x + ai_[j] * t[j].y; pi[j] = ai_[j] * t[j].x - ar[j] * t[j].y; }
                    u32x2 w0, w1; w0.x = cvt_pk_bf16(pr[0], pr[1]); w0.y = cvt_pk_bf16(pr[2], pr[3]); w1.x = cvt_pk_bf16(pi[0], pi[1]); w1.y = cvt_pk_bf16(pi[2], pi[3]);
                    *(u32x2*)(dst + s2) = w0; *(u32x2*)(dst + 128 + s2) = w1; }
#pragma unroll
                for (int j = 0; j < 4; ++j) { const float c = t[j].x * w16.x - t[j].y * w16.y, s = t[j].y * w16.x + t[j].x * w16.y; t[j].x = c; t[j].y = s; }
                asm volatile("" ::: "memory"); } }
    }
};
struct EpiF2 {
    static constexpr bool PERM = false;
    bf16_t* AOUT;
    __device__ __forceinline__ void operator()(const AccT& acc, const Unit& u, int wr, int wc, int fr, int fq) const {
        const int bk = u.pm >> 1, chalf = u.pm & 1, b = bk >> 7, k1 = bk & 127;
#pragma unroll
        for (int bj = 0; bj < 2; ++bj)
#pragma unroll
            for (int n = 0; n < 2; ++n) { const int k2 = wc * 32 + n * 16 + fr; bf16_t* rowp = AOUT + (size_t)(b * SEQ + k1 + 128 * k2) * KOUT + 512 + bj * 128;
#pragma unroll
                for (int ai = 0; ai < 2; ++ai)
#pragma unroll
                    for (int m = 0; m < 4; ++m) { const f32x4 v = acc[ai][bj][m][n];
                        u32x2 w; w.x = cvt_pk_bf16(v[0], v[1]); w.y = cvt_pk_bf16(v[2], v[3]);
                        *(u32x2*)(rowp + (chalf * 2 + ai) * 256 + wr * 64 + m * 16 + 4 * fq) = w; } }
    }
};
}

__device__ __forceinline__ void p0_transpose_item(const float* W, int ldsrc, int col0, int nblk, bf16_t* WT, int ldk, int row_off, LAS float* scr, int item, int lane) {
    const int kb = item / nblk, nb = item % nblk, k0 = 64 * kb, n0 = 32 * nb;
#pragma unroll 8
    for (int i = 0; i < 32; ++i) { const int kk = 2 * i + (lane >> 5); scr[kk * 33 + (lane & 31)] = W[(size_t)(k0 + kk) * ldsrc + col0 + n0 + (lane & 31)]; }
    asm volatile("s_waitcnt lgkmcnt(0)" ::: "memory");
    const int c = lane & 7;
#pragma unroll
    for (int j = 0; j < 4; ++j) { const int n = (lane >> 3) + 8 * j; const LAS float* s = scr + (8 * c) * 33 + n;
        u32x4 o; o.x = pk2(s[0 * 33], s[1 * 33]); o.y = pk2(s[2 * 33], s[3 * 33]); o.z = pk2(s[4 * 33], s[5 * 33]); o.w = pk2(s[6 * 33], s[7 * 33]);
        *(u32x4*)(WT + (size_t)(row_off + n0 + n) * ldk + k0 + 8 * c) = o; }
    asm volatile("s_waitcnt lgkmcnt(0)" ::: "memory");
}

struct Args {
    const float* x; const float* c; const float* w_ada; const float* b_ada; const float* w_in; const float* b_gate; const float* norm_w; const float* w_out;
    const float* ln1_g; const float* ln1_b; const float* w_ff1; const float* b_ff1; const float* w_ff2; const float* b_ff2; const float* ln2_g; const float* ln2_b;
    float* out; unsigned char* ws; int ldw; int pad;
};

__global__ void __launch_bounds__(512, 2) fwd_kernel(Args a) {
    extern __shared__ __attribute__((aligned(16))) unsigned char lds_raw[];
    LAS unsigned char* lds = (LAS unsigned char*)lds_raw;
    cg::grid_group grid = cg::this_grid();
    const int tid = threadIdx.x, lane = tid & 63, wave = __builtin_amdgcn_readfirstlane(tid >> 6);
    const int G = gridDim.x, blk = blockIdx.x;
    const int gw = blk * 8 + wave, NGW = G * 8;
    const int gt = blk * 512 + tid, NGT = G * 512;
#define mod ((float*)(a.ws + WS_MOD))
#define TW ((f32x2*)(a.ws + WS_TW))
#define ST1 ((f32x2*)(a.ws + WS_ST1))
#define MIN ((float*)(a.ws + WS_MIN))
#define SC ((f32x2*)(a.ws + WS_SC))
#define B1 ((bf16_t*)(a.ws + WS_B1))
#define B2 ((bf16_t*)(a.ws + WS_B2))
#define WCAT ((bf16_t*)(a.ws + WS_WCAT))
#define WOUT ((bf16_t*)(a.ws + WS_WOUT))
#define W1 ((bf16_t*)(a.ws + WS_W1))
#define W2 ((bf16_t*)(a.ws + WS_W2))
#define Hb ((bf16_t*)(a.ws + WS_H))
#define QK ((bf16_t*)(a.ws + WS_QK))
#define Vb ((bf16_t*)(a.ws + WS_V))
#define Ob ((bf16_t*)(a.ws + WS_O))
#define GATES ((float*)(a.ws + WS_GATES))
#define FZ ((bf16_t*)(a.ws + WS_FZ))
#define F1O ((bf16_t*)(a.ws + WS_F1O))
#define AOUT ((bf16_t*)(a.ws + WS_AOUT))
#define KVL ((float*)(a.ws + WS_KVL))
#define CST ((bf16_t*)(a.ws + WS_CST))
#define HID ((bf16_t*)(a.ws + WS_HID))
    const int ldw = a.ldw;

    {
        LAS float* trig = (LAS float*)(lds + 135168);
        if (tid < 128) { float s, c; sincospif((float)tid * (1.0f / 64.0f), &s, &c); trig[tid] = c; trig[128 + tid] = s; }
        if (blk < 96) {
            LAS float* sc = (LAS float*)lds;
            LAS float* red = (LAS float*)(lds + 8192);
            for (int i = tid; i < 2048; i += 512) { const float v = a.c[i]; sc[i] = v / (1.0f + expf(-v)); }
            __syncthreads();
            const int j0 = blk * 64 + lane; float a0 = 0.f, a1 = 0.f;
            const float* wp = a.w_ada + (size_t)(wave * 128) * 6144 + j0;
#pragma unroll 16
            for (int k = 0; k < 128; ++k) { const float w = wp[(size_t)k * 6144]; a0 += sc[wave * 128 + k] * w; a1 += sc[1024 + wave * 128 + k] * w; }
            red[(wave * 2 + 0) * 64 + lane] = a0; red[(wave * 2 + 1) * 64 + lane] = a1;
            __syncthreads();
            if (tid < 128) { const int b = tid >> 6, l = tid & 63; float s = a.b_ada[blk * 64 + l];
#pragma unroll
                for (int w = 0; w < 8; ++w) s += red[(w * 2 + b) * 64 + l];
                mod[b * 6144 + blk * 64 + l] = s; }
        }
        __syncthreads();
        LAS float* scr = (LAS float*)(lds + wave * 16384);
        constexpr int I_A = 16 * 48, I_B = 16 * 16, I_C = 8 * 32, I_D = 16 * 128, I_E = 64 * 32, NITEMS = I_A + I_B + I_C + I_D + I_E;
        for (int it = gw; it < NITEMS; it += NGW) {
            int r = it;
            if (r < I_A) { p0_transpose_item(a.w_in, ldw, 0, 48, WCAT, DM, 0, scr, r, lane); continue; } r -= I_A;
            if (r < I_B) { p0_transpose_item(a.w_in, ldw, 1536, 16, WCAT, DM, 1792, scr, r, lane); continue; } r -= I_B;
            if (r < I_C) { p0_transpose_item(a.w_out, DM, 0, 32, WOUT, KOUT, 0, scr, r, lane); continue; } r -= I_C;
            if (r < I_D) { p0_transpose_item(a.w_ff1, FF, 0, 128, W1, DM, 0, scr, r, lane); continue; } r -= I_D;
            p0_transpose_item(a.w_ff2, DM, 0, 32, W2, FF, 0, scr, r, lane);
        }
        for (int i = gt; i < 16 * 1024; i += NGT) { const int gcol = i >> 10, k = i & 1023; WCAT[(size_t)(1536 + gcol) * DM + k] = (bf16_t)f2bf(a.w_in[(size_t)k * ldw + 2048 + gcol]); }
        for (int i = gt; i < 240 * 128; i += NGT) *(u32x4*)(WCAT + (size_t)1552 * DM + (size_t)i * 8) = (u32x4){0u, 0u, 0u, 0u};
        const float isq = 0.08838834764831845f;
        for (int i = gt; i < 256 * 128; i += NGT) { const int n = i >> 7, s1 = i & 127, ri = n >> 7, k1 = n & 127; float s, c; sincospif((float)((k1 * s1) & 127) * (1.0f / 64.0f), &s, &c);
            B1[i] = (bf16_t)f2bf((ri ? -s : c) * isq); }
        for (int i = gt; i < 256 * 256; i += NGT) { const int n = i >> 8, kk = i & 255, ro = n >> 7, k2 = n & 127, ri = kk >> 7, s2 = kk & 127; float s, c; sincospif((float)((k2 * s2) & 127) * (1.0f / 64.0f), &s, &c);
            const float v = (ro == 0) ? (ri == 0 ? c : s) : (ri == 0 ? -s : c); B2[i] = (bf16_t)f2bf(v * isq); }
        for (int i = gt; i < 16384; i += NGT) { float s, c; sincospif((float)i * (1.0f / 8192.0f), &s, &c); TW[i] = (f32x2){c, s}; }
        for (int it = gw; it < 1024 * 16; it += NGW) {
            const int n = it >> 4, sub = it & 15, g = sub >> 2, ri = (sub >> 1) & 1, cc = (sub & 1) * 64 + lane;
            const float* wp = a.w_out + (size_t)(512 + 128 * g) * DM + n; const LAS float* tb = trig + ri * 128;
            float acc = 0.f;
#pragma unroll 8
            for (int cp = 0; cp < 128; ++cp) acc += wp[(size_t)cp * DM] * tb[(cc * cp) & 127];
            WOUT[(size_t)n * KOUT + 512 + g * 256 + ri * 128 + cc] = (bf16_t)f2bf(acc * isq);
        }
    }
    grid.sync();

    for (int m = gw; m < MT; m += NGW) {
        const f32x4* xr = (const f32x4*)(a.x + (size_t)m * DM) + lane;
        const float* mb = mod + (size_t)(m >> 14) * 6144;
        f32x4 v[4]; float s = 0.f;
#pragma unroll
        for (int j = 0; j < 4; ++j) { v[j] = xr[64 * j]; s += (v[j][0] + v[j][1]) + (v[j][2] + v[j][3]); }
        const float mean = wave_sum(s) * (1.f / DM); float s2 = 0.f;
#pragma unroll
        for (int j = 0; j < 4; ++j) { v[j] = v[j] - mean; s2 += (v[j][0] * v[j][0] + v[j][1] * v[j][1]) + (v[j][2] * v[j][2] + v[j][3] * v[j][3]); }
        const float rstd = 1.f / sqrtf(wave_sum(s2) * (1.f / DM) + LN_EPS);
        u32x2* o8 = (u32x2*)(Hb + (size_t)m * DM) + lane;
#pragma unroll
        for (int j = 0; j < 4; ++j) { const f32x4 sh = ((const f32x4*)mb)[lane + 64 * j], scv = ((const f32x4*)(mb + 1024))[lane + 64 * j] + 1.0f;
            const f32x4 y = v[j] * rstd * scv + sh; u32x2 w; w.x = pk2(y[0], y[1]); w.y = pk2(y[2], y[3]); o8[64 * j] = w; }
    }
    grid.sync();

    {
        pg8::Gemm g; g.A = Hb; g.Bt = WCAT + (size_t)1792 * DM; g.M = MT; g.N = 512; g.K = DM; g.lda = 128u * DM * 2u; g.hstep = (size_t)DM * 2; g.tdiv = 64; g.thi = (size_t)SEQ * DM * 2; g.tlo = (size_t)2 * DM * 2;
        pg8::StaticOrder S; S.init(MT, 512, G, blk);
        pg8::EpiF0 E{FZ};
        pg8::gemm_phase<pg8::EpiF0, true>(lds, g, S, E);
    }
    {
        pg8::Gemm g = pg8::std_gemm(Hb, WCAT, MT, 1792, DM);
        pg8::StaticOrder S; S.init(MT, 1792, G, blk);
        pg8::EpiMain E{QK, Vb, Ob, GATES, a.b_gate};
        pg8::gemm_phase<pg8::EpiMain, false>(lds, g, S, E);
    }
    grid.sync();

    {
        pg8::Gemm g = pg8::std_gemm(FZ, B1, NB * 512 * 128, 256, 128);
        pg8::StaticOrder S; S.init(NB * 512 * 128, 256, G, blk);
        pg8::EpiF1 E{F1O, TW};
        pg8::gemm_phase<pg8::EpiF1, true>(lds, g, S, E);
    }
    {
        LAS bf16_t* KsT = (LAS bf16_t*)lds;
        LAS bf16_t* VT = (LAS bf16_t*)(lds + 34816);
        LAS float* gl = (LAS float*)(lds + 69632);
        LAS float* gg = (LAS float*)(lds + 69632 + 2048);
        LAS float* wk = (LAS float*)(lds + 69632 + 3072);
        const int fr = lane & 15, fq = lane >> 4;
        for (int u = blk; u < NB * NH * NCHUNK; u += G) {
            const int chunk = u & 127, h = (u >> 7) & 3, b = u >> 9; const size_t tok0 = (size_t)b * SEQ + chunk * 128;
            const int chain_f = (b * NH + h) * 2;
            __syncthreads();
            if (tid < 128) {
#pragma unroll
                for (int ty = 0; ty < 4; ++ty) gl[ty * 128 + tid] = GATES[(tok0 + tid) * 16 + ty * 4 + h];
            }
            __syncthreads();
            if (tid < 128) {
                float bf_ = 0.f, totf = 0.f, br_ = 0.f, totb = 0.f;
                for (int r = 0; r < 128; ++r) { const float f = gl[128 + r], fb = gl[384 + r]; totf += f; totb += fb; bf_ += (r <= tid) ? f : 0.f; br_ += (r >= tid) ? fb : 0.f; }
                gg[tid] = totf - bf_ + gl[tid]; gg[128 + tid] = totb - br_ + gl[256 + tid];
                if (tid == 0) { wk[0] = totf; wk[1] = totb; }
            }
            __syncthreads();
            float mlf = -3.0e38f, mlb = -3.0e38f;
            if (tid < 128) {
                for (int r = 0; r < 128; ++r) { mlf = fmaxf(mlf, gg[r]); mlb = fmaxf(mlb, gg[128 + r]); }
                if (tid == 0) { SC[(size_t)chain_f * 128 + chunk] = (f32x2){wk[0], mlf}; SC[(size_t)(chain_f + 1) * 128 + chunk] = (f32x2){wk[1], mlb}; }
            }
            __syncthreads();
            if (tid < 128) { wk[tid] = expf(gg[tid] - mlf); wk[128 + tid] = expf(gg[128 + tid] - mlb); }
            __syncthreads();
            {
                const int s = tid >> 2, q4 = tid & 3; const float wf = wk[s], wb = wk[128 + s];
                const bf16_t* kp = QK + (tok0 + s) * 512 + 256 + h * 64 + q4 * 16;
                const bf16x8 k0 = *(const bf16x8*)kp, k1 = *(const bf16x8*)(kp + 8);
#pragma unroll
                for (int j = 0; j < 8; ++j) { const float a0 = bf2f((unsigned short)k0[j]), a1 = bf2f((unsigned short)k1[j]); const int d0 = q4 * 16 + j, d1 = d0 + 8;
                    KsT[d0 * 136 + s] = (bf16_t)f2bf(a0 * wf); KsT[d1 * 136 + s] = (bf16_t)f2bf(a1 * wf);
                    KsT[(64 + d0) * 136 + s] = (bf16_t)f2bf(a0 * wb); KsT[(64 + d1) * 136 + s] = (bf16_t)f2bf(a1 * wb); }
                const bf16_t* vp = Vb + (tok0 + s) * 512 + h * 128 + q4 * 32;
#pragma unroll
                for (int c = 0; c < 4; ++c) { const bf16x8 vv = *(const bf16x8*)(vp + c * 8);
#pragma unroll
                    for (int j = 0; j < 8; ++j) VT[(q4 * 32 + c * 8 + j) * 136 + s] = (bf16_t)vv[j]; }
            }
            __syncthreads();
            {
                f32x4 acc[8];
#pragma unroll
                for (int n = 0; n < 8; ++n) acc[n] = (f32x4){0.f, 0.f, 0.f, 0.f};
#pragma unroll
                for (int ks = 0; ks < 4; ++ks) { const bf16x8 af = *(const LAS bf16x8*)(KsT + (wave * 16 + fr) * 136 + ks * 32 + fq * 8);
#pragma unroll
                    for (int n = 0; n < 8; ++n) { const bf16x8 bfv = *(const LAS bf16x8*)(VT + (n * 16 + fr) * 136 + ks * 32 + fq * 8);
                        acc[n] = __builtin_amdgcn_mfma_f32_16x16x32_bf16(af, bfv, acc[n], 0, 0, 0); } }
                const int dir = wave >> 2, d = (wave & 3) * 16 + 4 * fq;
                float* dst = KVL + ((size_t)(chain_f + dir) * 128 + chunk) * ST_ROW;
#pragma unroll
                for (int n = 0; n < 8; ++n) *(f32x4*)(dst + (n * 16 + fr) * 64 + d) = acc[n];
                if (tid < 128) { float s = 0.f; for (int r = 0; r < 128; ++r) s += bf2f(KsT[tid * 136 + r]);
                    KVL[((size_t)(chain_f + (tid >> 6)) * 128 + chunk) * ST_ROW + 128 * 64 + (tid & 63)] = s; }
            }
        }
        __syncthreads();
    }
    grid.sync();

    if (gt < 16 * (ST_ROW / 2)) {
        const int chain = gt / (ST_ROW / 2), p = gt % (ST_ROW / 2), dir = chain & 1;
        const float* src = KVL + (size_t)chain * 128 * ST_ROW + 2 * p; bf16_t* dst = CST + (size_t)chain * 128 * ST_ROW + 2 * p;
        const f32x2* scp = SC + (size_t)chain * 128; float* mo = MIN + chain * 128;
        float c0 = 0.f, c1 = 0.f, m = 0.f;
        for (int i0 = 0; i0 < 128; i0 += 8) {
            f32x2 kv[8], sc[8];
#pragma unroll
            for (int q = 0; q < 8; ++q) { const int j = dir ? 127 - (i0 + q) : (i0 + q); kv[q] = *(const f32x2*)(src + (size_t)j * ST_ROW); sc[q] = scp[j]; }
#pragma unroll
            for (int q = 0; q < 8; ++q) { const int j = dir ? 127 - (i0 + q) : (i0 + q);
                *(unsigned*)(dst + (size_t)j * ST_ROW) = pk2(c0, c1); if (p == 0) mo[j] = m;
                const float mn = fmaxf(sc[q].x + m, sc[q].y), dec = expf(sc[q].x + m - mn), wl = expf(sc[q].y - mn);
                c0 = dec * c0 + wl * kv[q].x; c1 = dec * c1 + wl * kv[q].y; m = mn; }
        }
    }
    {
        pg8::Gemm g = pg8::std_gemm(F1O, B2, NB * 128 * 512, 256, 256);
        pg8::StaticOrder S; S.init(NB * 128 * 512, 256, G, blk);
        pg8::EpiF2 E{AOUT};
        pg8::gemm_phase<pg8::EpiF2, true>(lds, g, S, E);
    }
    grid.sync();

    {
        LAS bf16_t* Kx = (LAS bf16_t*)lds;
        LAS bf16_t* VT = (LAS bf16_t*)(lds + 20736);
        LAS bf16_t* CfT = (LAS bf16_t*)(lds + 55552);
        LAS bf16_t* CbT = (LAS bf16_t*)(lds + 73984);
        LAS float* gl = (LAS float*)(lds + 92416);
        LAS float* sa = (LAS float*)(lds + 92416 + 2048);
        LAS float* sr = (LAS float*)(lds + 92416 + 4096);
        const int fr = lane & 15, fq = lane >> 4;
        for (int u = blk; u < NB * NH * NCHUNK; u += G) {
            const int h = u & 3, chunk = (u >> 2) & 127, b = u >> 9; const size_t tok0 = (size_t)b * SEQ + chunk * 128;
            const int chain_f = (b * NH + h) * 2;
            const bf16_t* cf = CST + ((size_t)chain_f * 128 + chunk) * ST_ROW; const bf16_t* cb = CST + ((size_t)(chain_f + 1) * 128 + chunk) * ST_ROW;
            __syncthreads();
            if (tid < 128) {
#pragma unroll
                for (int ty = 0; ty < 4; ++ty) gl[ty * 128 + tid] = GATES[(tok0 + tid) * 16 + ty * 4 + h];
            }
            {
#pragma unroll
                for (int i = 0; i < 2; ++i) { const int c = tid + i * 512, s = c >> 3, part = c & 7;
                    *(LAS u32x4*)(Kx + s * 72 + part * 8) = *(const u32x4*)(QK + (tok0 + s) * 512 + 256 + h * 64 + part * 8);
                    *(LAS u32x4*)(CfT + s * 72 + part * 8) = *(const u32x4*)(cf + s * 64 + part * 8);
                    *(LAS u32x4*)(CbT + s * 72 + part * 8) = *(const u32x4*)(cb + s * 64 + part * 8); }
                if (tid < 16) { const int r = tid >> 3, part = tid & 7; *(LAS u32x4*)(Kx + (128 + r) * 72 + part * 8) = *(const u32x4*)((r ? cb : cf) + 128 * 64 + part * 8); }
                else if (tid >= 64 && tid < 64 + 14 * 9) { const int c = tid - 64; *(LAS u32x4*)(Kx + 130 * 72 + c * 8) = (u32x4){0u, 0u, 0u, 0u}; }
                const int s = tid >> 2, q4 = tid & 3;
                const bf16_t* vp = Vb + (tok0 + s) * 512 + h * 128 + q4 * 32;
#pragma unroll
                for (int c = 0; c < 4; ++c) { const bf16x8 vv = *(const bf16x8*)(vp + c * 8);
#pragma unroll
                    for (int j = 0; j < 8; ++j) VT[(q4 * 32 + c * 8 + j) * 136 + s] = (bf16_t)vv[j]; }
            }
            __syncthreads();
            const float m_f = MIN[chain_f * 128 + chunk], m_b = MIN[(chain_f + 1) * 128 + chunk];
            if (tid < 128) {
                float bf_ = 0.f, br_ = 0.f;
                for (int r = 0; r < 128; ++r) { const float f = gl[128 + r], fb = gl[384 + r]; bf_ += (r <= tid) ? f : 0.f; br_ += (r >= tid) ? fb : 0.f; }
                sa[tid] = gl[tid] - bf_; sa[128 + tid] = gl[256 + tid] - br_; sa[256 + tid] = bf_; sa[384 + tid] = br_;
            }
            __syncthreads();
            if (tid < 128) {
                float Mf = m_f, Mb = m_b;
                for (int r = 0; r < 128; ++r) { const float x0 = sa[r], x1 = sa[128 + r]; Mf = (r <= tid) ? fmaxf(Mf, x0) : Mf; Mb = (r >= tid) ? fmaxf(Mb, x1) : Mb; }
                sr[tid] = Mf; sr[128 + tid] = Mb; sr[256 + tid] = expf(m_f - Mf); sr[384 + tid] = expf(m_b - Mb);
                sr[512 + tid] = expf(-sa[256 + tid] - Mf); sr[640 + tid] = expf(-sa[384 + tid] - Mb);
            }
            __syncthreads();
            {
                const int t = wave * 16 + fr;
                const bf16_t* qp = QK + (tok0 + t) * 512 + h * 64 + fq * 8;
                const bf16x8 q0 = *(const bf16x8*)qp, q1 = *(const bf16x8*)(qp + 32);
                f32x4 sacc[9];
#pragma unroll
                for (int n = 0; n < 9; ++n) { sacc[n] = (f32x4){0.f, 0.f, 0.f, 0.f};
                    const bf16x8 kf0 = *(const LAS bf16x8*)(Kx + (n * 16 + fr) * 72 + fq * 8), kf1 = *(const LAS bf16x8*)(Kx + (n * 16 + fr) * 72 + 32 + fq * 8);
                    sacc[n] = __builtin_amdgcn_mfma_f32_16x16x32_bf16(kf0, q0, sacc[n], 0, 0, 0);
                    sacc[n] = __builtin_amdgcn_mfma_f32_16x16x32_bf16(kf1, q1, sacc[n], 0, 0, 0); }
                const float qnf = __shfl(sacc[8][0], fr), qnb = __shfl(sacc[8][1], fr);
                const float Mf = sr[t], Mb = sr[128 + t], wif = sr[256 + t], wib = sr[384 + t], flf = sr[512 + t], flb = sr[640 + t];
                float pf[8][4], pb[8][4]; float sumf = 0.f, sumb = 0.f;
#pragma unroll
                for (int n = 0; n < 8; ++n)
#pragma unroll
                    for (int j = 0; j < 4; ++j) { const int s = n * 16 + 4 * fq + j; const float sv = sacc[n][j] * 0.125f;
                        const float wf = (s <= t) ? expf(sa[s] - Mf) : 0.f, wb = (s >= t) ? expf(sa[128 + s] - Mb) : 0.f;
                        pf[n][j] = sv * wf; pb[n][j] = sv * wb; sumf += pf[n][j]; sumb += pb[n][j]; }
                sumf += __shfl_xor(sumf, 16); sumf += __shfl_xor(sumf, 32); sumb += __shfl_xor(sumb, 16); sumb += __shfl_xor(sumb, 32);
                const float denf = sumf + wif * 0.125f * qnf, denb = sumb + wib * 0.125f * qnb;
                const float rf = 1.0f / fmaxf(fabsf(denf), flf), rb = 1.0f / fmaxf(fabsf(denb), flb);
                bf16x8 pfr[4], qaf[2], qab[2];
#pragma unroll
                for (int ks = 0; ks < 4; ++ks) { u32x4 w;
                    w.x = pk2(pf[2 * ks][0] * rf + pb[2 * ks][0] * rb, pf[2 * ks][1] * rf + pb[2 * ks][1] * rb); w.y = pk2(pf[2 * ks][2] * rf + pb[2 * ks][2] * rb, pf[2 * ks][3] * rf + pb[2 * ks][3] * rb);
                    w.z = pk2(pf[2 * ks + 1][0] * rf + pb[2 * ks + 1][0] * rb, pf[2 * ks + 1][1] * rf + pb[2 * ks + 1][1] * rb); w.w = pk2(pf[2 * ks + 1][2] * rf + pb[2 * ks + 1][2] * rb, pf[2 * ks + 1][3] * rf + pb[2 * ks + 1][3] * rb);
                    pfr[ks] = __builtin_bit_cast(bf16x8, w); }
                const float cfw = 0.125f * rf * wif, cbw = 0.125f * rb * wib;
#pragma unroll
                for (int ks = 0; ks < 2; ++ks) { const bf16x8 qv = ks ? q1 : q0; u32x4 wfv, wbv; unsigned tf[4], tb[4];
#pragma unroll
                    for (int j = 0; j < 4; ++j) { const float e0 = bf2f((unsigned short)qv[2 * j]), e1 = bf2f((unsigned short)qv[2 * j + 1]); tf[j] = pk2(e0 * cfw, e1 * cfw); tb[j] = pk2(e0 * cbw, e1 * cbw); }
                    wfv = (u32x4){tf[0], tf[1], tf[2], tf[3]}; wbv = (u32x4){tb[0], tb[1], tb[2], tb[3]};
                    qaf[ks] = __builtin_bit_cast(bf16x8, wfv); qab[ks] = __builtin_bit_cast(bf16x8, wbv); }
                f32x4 oacc[8];
#pragma unroll
                for (int ne = 0; ne < 8; ++ne) { oacc[ne] = (f32x4){0.f, 0.f, 0.f, 0.f}; const int e = ne * 16 + fr;
#pragma unroll
                    for (int ks = 0; ks < 4; ++ks) { const bf16x4 lo = *(const LAS bf16x4*)(VT + e * 136 + ks * 32 + 4 * fq), hi = *(const LAS bf16x4*)(VT + e * 136 + ks * 32 + 16 + 4 * fq);
                        const bf16x8 vf = (bf16x8){lo[0], lo[1], lo[2], lo[3], hi[0], hi[1], hi[2], hi[3]};
                        oacc[ne] = __builtin_amdgcn_mfma_f32_16x16x32_bf16(vf, pfr[ks], oacc[ne], 0, 0, 0); }
#pragma unroll
                    for (int ks = 0; ks < 2; ++ks) { const bf16x8 c1 = *(const LAS bf16x8*)(CfT + e * 72 + ks * 32 + fq * 8), c2 = *(const LAS bf16x8*)(CbT + e * 72 + ks * 32 + fq * 8);
                        oacc[ne] = __builtin_amdgcn_mfma_f32_16x16x32_bf16(c1, qaf[ks], oacc[ne], 0, 0, 0);
                        oacc[ne] = __builtin_amdgcn_mfma_f32_16x16x32_bf16(c2, qab[ks], oacc[ne], 0, 0, 0); } }
                float s1 = 0.f;
#pragma unroll
                for (int ne = 0; ne < 8; ++ne) s1 += (oacc[ne][0] + oacc[ne][1]) + (oacc[ne][2] + oacc[ne][3]);
                s1 += __shfl_xor(s1, 16); s1 += __shfl_xor(s1, 32);
                const float mu = s1 * (1.0f / 128.0f); float s2 = 0.f;
#pragma unroll
                for (int ne = 0; ne < 8; ++ne) { oacc[ne] = oacc[ne] - mu; s2 += (oacc[ne][0] * oacc[ne][0] + oacc[ne][1] * oacc[ne][1]) + (oacc[ne][2] * oacc[ne][2] + oacc[ne][3] * oacc[ne][3]); }
                s2 += __shfl_xor(s2, 16); s2 += __shfl_xor(s2, 32);
                const float rstd = 1.0f / sqrtf(s2 * (1.0f / 128.0f) + LN_EPS);
                const bf16_t* op = Ob + (tok0 + t) * 512 + h * 128 + 4 * fq; bf16_t* yp = AOUT + (tok0 + t) * KOUT + h * 128 + 4 * fq; const float* nw = a.norm_w + h * 128 + 4 * fq;
#pragma unroll
                for (int ne = 0; ne < 8; ++ne) { const bf16x4 ov = *(const bf16x4*)(op + ne * 16); const f32x4 wv = *(const f32x4*)(nw + ne * 16); float y[4];
#pragma unroll
                    for (int j = 0; j < 4; ++j) { const float og = bf2f((unsigned short)ov[j]); y[j] = oacc[ne][j] * rstd * wv[j] / (1.0f + expf(-og)); }
                    u32x2 w; w.x = pk2(y[0], y[1]); w.y = pk2(y[2], y[3]); *(u32x2*)(yp + ne * 16) = w; }
            }
        }
        __syncthreads();
    }
    grid.sync();

    {
        pg8::Gemm g = pg8::std_gemm(AOUT, WOUT, MT, DM, KOUT);
        pg8::StaticOrder S; S.init(MT, DM, G, blk);
        pg8::EpiOut E{a.x, a.out, mod};
        pg8::gemm_phase<pg8::EpiOut, false>(lds, g, S, E);
    }
    grid.sync();

    for (int m = gw; m < MT; m += NGW) {
        const f32x4* ur = (const f32x4*)(a.out + (size_t)m * DM) + lane;
        const float* mb = mod + (size_t)(m >> 14) * 6144;
        f32x4 v[4]; float s = 0.f;
#pragma unroll
        for (int j = 0; j < 4; ++j) { v[j] = ur[64 * j]; s += (v[j][0] + v[j][1]) + (v[j][2] + v[j][3]); }
        const float mean = wave_sum(s) * (1.f / DM); float s2 = 0.f;
#pragma unroll
        for (int j = 0; j < 4; ++j) { v[j] = v[j] - mean; s2 += (v[j][0] * v[j][0] + v[j][1] * v[j][1]) + (v[j][2] * v[j][2] + v[j][3] * v[j][3]); }
        const float rstd = 1.f / sqrtf(wave_sum(s2) * (1.f / DM) + LN_EPS);
        if (lane == 0) ST1[m] = (f32x2){mean, rstd};
        float t = 0.f;
#pragma unroll
        for (int j = 0; j < 4; ++j) { const f32x4 lg = ((const f32x4*)a.ln1_g)[lane + 64 * j], lb = ((const f32x4*)a.ln1_b)[lane + 64 * j]; v[j] = v[j] * rstd * lg + lb; t += (v[j][0] + v[j][1]) + (v[j][2] + v[j][3]); }
        const float mean2 = wave_sum(t) * (1.f / DM); float t2 = 0.f;
#pragma unroll
        for (int j = 0; j < 4; ++j) { v[j] = v[j] - mean2; t2 += (v[j][0] * v[j][0] + v[j][1] * v[j][1]) + (v[j][2] * v[j][2] + v[j][3] * v[j][3]); }
        const float rstd2 = 1.f / sqrtf(wave_sum(t2) * (1.f / DM) + LN_EPS);
        u32x2* o8 = (u32x2*)(Hb + (size_t)m * DM) + lane;
#pragma unroll
        for (int j = 0; j < 4; ++j) { const f32x4 sh = ((const f32x4*)(mb + 3072))[lane + 64 * j], scv = ((const f32x4*)(mb + 4096))[lane + 64 * j] + 1.0f;
            const f32x4 y = v[j] * rstd2 * scv + sh; u32x2 w; w.x = pk2(y[0], y[1]); w.y = pk2(y[2], y[3]); o8[64 * j] = w; }
    }
    grid.sync();

    {
        pg8::Gemm g = pg8::std_gemm(Hb, W1, MT, FF, DM);
        pg8::StaticOrder S; S.init(MT, FF, G, blk);
        pg8::EpiFF1 E{HID, a.b_ff1};
        pg8::gemm_phase<pg8::EpiFF1, false>(lds, g, S, E);
    }
    grid.sync();

    {
        pg8::Gemm g = pg8::std_gemm(HID, W2, MT, DM, FF);
        pg8::StaticOrder S; S.init(MT, DM, G, blk);
        pg8::EpiFF2 E{a.out, mod, ST1, a.ln1_g, a.ln1_b, a.b_ff2};
        pg8::gemm_phase<pg8::EpiFF2, false>(lds, g, S, E);
    }
    grid.sync();

    for (int m = gw; m < MT; m += NGW) {
        f32x4* ur = (f32x4*)(a.out + (size_t)m * DM) + lane;
        f32x4 v[4]; float s = 0.f;
#pragma unroll
        for (int j = 0; j < 4; ++j) { v[j] = ur[64 * j]; s += (v[j][0] + v[j][1]) + (v[j][2] + v[j][3]); }
        const float mean = wave_sum(s) * (1.f / DM); float s2 = 0.f;
#pragma unroll
        for (int j = 0; j < 4; ++j) { v[j] = v[j] - mean; s2 += (v[j][0] * v[j][0] + v[j][1] * v[j][1]) + (v[j][2] * v[j][2] + v[j][3] * v[j][3]); }
        const float rstd = 1.f / sqrtf(wave_sum(s2) * (1.f / DM) + LN_EPS);
#pragma unroll
        for (int j = 0; j < 4; ++j) { const f32x4 lg = ((const f32x4*)a.ln2_g)[lane + 64 * j], lb = ((const f32x4*)a.ln2_b)[lane + 64 * j]; ur[64 * j] = v[j] * rstd * lg + lb; }
    }
}

extern "C" void kernel_launch(void* const* d_in, const int* in_sizes, int n_in, void* d_out, int out_size, void* d_ws, size_t ws_size, hipStream_t stream) {
    static int grid = 0;
    if (grid == 0) {
        if (n_in != 16 || out_size != MT * DM || ws_size < WS_END) { fprintf(stderr, "kernel_launch: unexpected shapes (n_in %d, out %d, ws %zu)\n", n_in, out_size, ws_size); grid = -1; return; }
        int dev = 0, cus = 0, per_cu = 0;
        hipGetDevice(&dev);
        hipDeviceGetAttribute(&cus, hipDeviceAttributeMultiprocessorCount, dev);
        hipFuncSetAttribute((const void*)fwd_kernel, hipFuncAttributeMaxDynamicSharedMemorySize, LDS_BYTES);
        hipOccupancyMaxActiveBlocksPerMultiprocessor(&per_cu, (const void*)fwd_kernel, 512, LDS_BYTES);
        if (per_cu < 1) per_cu = 1;
        grid = cus * per_cu;
        if (grid > 256) grid = 256;
        (void)hipGetLastError();
    }
    if (grid < 0) return;
    Args a{};
    a.x = (const float*)d_in[0]; a.c = (const float*)d_in[1]; a.w_ada = (const float*)d_in[2]; a.b_ada = (const float*)d_in[3]; a.w_in = (const float*)d_in[4];
    a.b_gate = (const float*)d_in[5]; a.norm_w = (const float*)d_in[6]; a.w_out = (const float*)d_in[7]; a.ln1_g = (const float*)d_in[8]; a.ln1_b = (const float*)d_in[9];
    a.w_ff1 = (const float*)d_in[10]; a.b_ff1 = (const float*)d_in[11]; a.w_ff2 = (const float*)d_in[12]; a.b_ff2 = (const float*)d_in[13]; a.ln2_g = (const float*)d_in[14]; a.ln2_b = (const float*)d_in[15];
    a.out = (float*)d_out; a.ws = (unsigned char*)d_ws; a.ldw = in_sizes[4] / DM; a.pad = 0;
    void* args[] = {&a};
    hipError_t e = hipLaunchCooperativeKernel((const void*)fwd_kernel, dim3(grid), dim3(512), args, LDS_BYTES, stream);
    if (e != hipSuccess) fprintf(stderr, "cooperative launch failed: %s (grid %d)\n", hipGetErrorString(e), grid);
}
```

```cpp
#include <hip/hip_runtime.h>
#include <hip/hip_cooperative_groups.h>
#include <cstdio>
#include <cstdint>
namespace cg = cooperative_groups;

#define LAS __attribute__((address_space(3)))
typedef unsigned short bf16_t;
typedef short bf16x8 __attribute__((ext_vector_type(8)));
typedef short bf16x4 __attribute__((ext_vector_type(4)));
typedef float f32x4 __attribute__((ext_vector_type(4)));
typedef float f32x2 __attribute__((ext_vector_type(2)));
typedef unsigned u32x4 __attribute__((ext_vector_type(4)));
typedef unsigned u32x2 __attribute__((ext_vector_type(2)));

constexpr int NB = 2, SEQ = 16384, DM = 1024, MT = NB * SEQ, FF = 4096, NH = 4;
constexpr int NCHUNK = 128;
constexpr int NCAT = 2304;
constexpr int KOUT = 1536;
constexpr float LN_EPS = 1e-5f;
constexpr float ALPHA = 1.189207115002721f;
constexpr int ST_ROW = 129 * 64;

constexpr size_t KiB = 1024, MiB = 1u << 20;
constexpr size_t WS_MOD = 0, WS_TW = 64 * KiB, WS_ST1 = 192 * KiB, WS_MIN = 448 * KiB, WS_SC = 456 * KiB, WS_B1 = 512 * KiB, WS_B2 = 576 * KiB;
constexpr size_t WS_B1F = 704 * KiB, WS_TS = 768 * KiB, WS_BAR = 832 * KiB, WS_WTMP = 25 * MiB;
constexpr size_t WS_WCAT = 1 * MiB, WS_WOUT = 6 * MiB, WS_W1 = 9 * MiB, WS_W2 = 17 * MiB;
constexpr size_t WS_H = 32 * MiB;
constexpr size_t WS_QK = 96 * MiB, WS_V = 128 * MiB, WS_O = 160 * MiB, WS_GATES = 192 * MiB, WS_FZ = 194 * MiB, WS_F1O = 226 * MiB, WS_AOUT = 290 * MiB,
                 WS_KVL = 386 * MiB, WS_CST = 452 * MiB, WS_END = 486 * MiB;
constexpr size_t WS_HID = 96 * MiB;
constexpr int LDS_BYTES = 147456;

__device__ __forceinline__ unsigned f2bf(float f) { unsigned u = __builtin_bit_cast(unsigned, f); return (u + 0x7fffu + ((u >> 16) & 1u)) >> 16; }
__device__ __forceinline__ unsigned pk2(float lo, float hi) { return f2bf(lo) | (f2bf(hi) << 16); }
__device__ __forceinline__ float bf2f(unsigned short h) { return __builtin_bit_cast(float, (unsigned)h << 16); }
__device__ __forceinline__ float wave_sum(float v) {
#pragma unroll
    for (int o = 1; o < 64; o <<= 1) v += __shfl_xor(v, o);
    return v;
}
__device__ __forceinline__ float log_sigmoid(float x) { return fminf(x, 0.f) - __logf(1.0f + __expf(-fabsf(x))); }

namespace pg8 {
constexpr int BM = 256, BK = 64, HALF = 128, HTB = HALF * BK * 2, STAGE_BYTES = 8 * HTB, NXCD = 8, WGM = 8;
__host__ __device__ __forceinline__ int lds_byte(int r, int c) { const int st = (r >> 4) * 2 + (c >> 5), rr = r & 15, cc = c & 31, ob = rr * 64 + cc * 2; return st * 1024 + (ob ^ (((ob >> 9) & 1) << 5)); }
__host__ __device__ __forceinline__ void stage_rc(int b, int& R, int& C) { const int st = b / 1024, sb = b % 1024, swz = sb ^ (((sb >> 9) & 1) << 5); R = (st >> 1) * 16 + swz / 64; C = (st & 1) * 32 + (swz % 64) / 2; }
__host__ __device__ __forceinline__ int perm32(int rho) { const int n = rho >> 4, i = rho & 15; return 8 * (i >> 2) + 4 * n + (i & 3); }

struct Unit { int pm, pn; };
struct Gemm { const bf16_t* A; const bf16_t* Bt; int M, N, K; unsigned lda; size_t hstep; int tdiv; size_t thi, tlo; };
__device__ __forceinline__ Gemm std_gemm(const bf16_t* A, const bf16_t* Bt, int M, int N, int K) {
    Gemm g; g.A = A; g.Bt = Bt; g.M = M; g.N = N; g.K = K; g.lda = (unsigned)K * 2u; g.hstep = (size_t)HALF * K * 2; g.tdiv = 1 << 30; g.thi = 0; g.tlo = (size_t)BM * K * 2; return g;
}

struct StaticOrder {
    int nM, nN, nwg, G, c;
    __device__ void init(int M, int N, int G_, int c_) { nM = M / BM; nN = N / BM; nwg = nM * nN; G = G_; c = c_; }
    __device__ bool next(int i, Unit& u) const {
        const long L = (long)i * G + c; if (L >= nwg) return false;
        int wgid = (int)L; { const int q = nwg / NXCD, r = nwg % NXCD, xcd = wgid % NXCD, off = wgid / NXCD; wgid = (xcd < r ? xcd * (q + 1) : r * (q + 1) + (xcd - r) * q) + off; }
        const int nig = WGM * nN, gid = wgid / nig, fm = gid * WGM, gsz = (nM - fm) < WGM ? (nM - fm) : WGM;
        u.pm = fm + ((wgid % nig) % gsz); u.pn = (wgid % nig) / gsz; return true;
    }
};

__device__ __forceinline__ unsigned cvt_pk_bf16(float lo, float hi) { unsigned r; asm volatile("v_cvt_pk_bf16_f32 %0, %1, %2" : "=v"(r) : "v"(lo), "v"(hi)); return r; }

template <class Epi, bool SWAP>
__device__ __forceinline__ void gemm_phase(LAS unsigned char* lds, const Gemm g, const StaticOrder& S, const Epi& E) {
    int tid_ = threadIdx.x; asm volatile("" : "+v"(tid_));
    const int tid = tid_, wid = __builtin_amdgcn_readfirstlane(tid >> 6), lane = tid & 63, wr = wid >> 2, wc = wid & 3, fr = lane & 15, fq = lane >> 4;
    const int K = g.K, nt = K / BK;
    unsigned voffA[2], voffB[2];
#pragma unroll
    for (int i = 0; i < 2; ++i) { int R, C; stage_rc(tid * 16 + i * 8192, R, C); const int Rb = (Epi::PERM && !SWAP) ? ((R & ~31) + perm32(R & 31)) : R;
        voffA[i] = (unsigned)R * g.lda + (unsigned)C * 2u; voffB[i] = (unsigned)(Rb * K + C) * 2u; }
    const size_t kstep = (size_t)(BK * 2);
    const size_t hstepA = g.hstep;
    const size_t hstepB = (size_t)HALF * K * 2, tstepB = 2 * hstepB;
    const unsigned ldsw = (unsigned)wid * 1024u;
    const int aoff = lds_byte(wr * 64 + fr, fq * 8), boff = lds_byte(wc * 32 + fr, fq * 8);
#define PG8_SA(b, h) (((b) * 2 + (h)) * HTB)
#define PG8_SB(b, h) ((4 + (b) * 2 + (h)) * HTB)
#define PG8_ABASE(pm) ((const char*)g.A + (size_t)((pm) / g.tdiv) * g.thi + (size_t)((pm) % g.tdiv) * g.tlo)
#define PG8_STAGE(bufoff, gbase, voff) do { _Pragma("unroll") for (int _i = 0; _i < 2; ++_i) \
        __builtin_amdgcn_global_load_lds((const unsigned*)((const char*)(gbase) + (voff)[_i]), (LAS unsigned*)(lds + (bufoff) + ldsw + _i * 8192), 16, 0, 0); } while (0)
#define PG8_LDA(dst, b, h) do { _Pragma("unroll") for (int m = 0; m < 4; ++m) _Pragma("unroll") for (int k = 0; k < 2; ++k) dst[m][k] = *(const LAS bf16x8*)(lds + PG8_SA(b, h) + aoff + m * 2048 + k * 1024); } while (0)
#define PG8_LDB(dst, b, h) do { _Pragma("unroll") for (int n = 0; n < 2; ++n) _Pragma("unroll") for (int k = 0; k < 2; ++k) dst[n][k] = *(const LAS bf16x8*)(lds + PG8_SB(b, h) + boff + n * 2048 + k * 1024); } while (0)
#define PG8_MMA(ai, bj, At, Bt) do { __builtin_amdgcn_s_setprio(1); _Pragma("unroll") for (int m = 0; m < 4; ++m) _Pragma("unroll") for (int n = 0; n < 2; ++n) _Pragma("unroll") for (int k = 0; k < 2; ++k) \
        acc[ai][bj][m][n] = SWAP ? __builtin_amdgcn_mfma_f32_16x16x32_bf16(At[m][k], Bt[n][k], acc[ai][bj][m][n], 0, 0, 0) \
                                 : __builtin_amdgcn_mfma_f32_16x16x32_bf16(Bt[n][k], At[m][k], acc[ai][bj][m][n], 0, 0, 0); __builtin_amdgcn_s_setprio(0); } while (0)
#define PG8_WAIT_V(n) asm volatile("s_waitcnt vmcnt(" #n ")" ::: "memory")
#define PG8_WAIT_L(n) asm volatile("s_waitcnt lgkmcnt(" #n ")" ::: "memory")
#define PG8_BAR __builtin_amdgcn_s_barrier()
#define PG8_SCHED __builtin_amdgcn_sched_barrier(0)
    Unit cur, nxt; int ui = 0;
    if (!S.next(0, cur)) return;
    f32x4 acc[2][2][4][2];
#pragma unroll
    for (int a = 0; a < 2; ++a)
#pragma unroll
        for (int b = 0; b < 2; ++b)
#pragma unroll
            for (int m = 0; m < 4; ++m)
#pragma unroll
                for (int n = 0; n < 2; ++n) acc[a][b][m][n] = (f32x4){0.f, 0.f, 0.f, 0.f};
    bf16x8 At[4][2], B0[2][2], B1[2][2];
    const char* cA = PG8_ABASE(cur.pm); const char* cB = (const char*)g.Bt + (size_t)cur.pn * tstepB;
    PG8_STAGE(PG8_SB(0, 0), cB, voffB); PG8_STAGE(PG8_SB(0, 1), cB + hstepB, voffB); PG8_STAGE(PG8_SA(0, 0), cA, voffA); PG8_STAGE(PG8_SA(0, 1), cA + hstepA, voffA);
    if (wr == 1) PG8_BAR;
    PG8_WAIT_V(2); PG8_BAR;
    PG8_STAGE(PG8_SB(1, 0), cB + kstep, voffB); PG8_STAGE(PG8_SA(1, 0), cA + kstep, voffA); PG8_STAGE(PG8_SB(1, 1), cB + hstepB + kstep, voffB);
    PG8_WAIT_V(6); PG8_BAR;
    for (;;) {
        const bool has_next = S.next(ui + 1, nxt);
        const char* nA = has_next ? PG8_ABASE(nxt.pm) : cA; const char* nB = has_next ? (const char*)g.Bt + (size_t)nxt.pn * tstepB : cB;
        for (int t = 0; t < nt; t += 2) {
            const bool last = (t == nt - 2);
            const char* a1 = cA + (size_t)(t + 1) * kstep;
            const char* a2 = last ? nA : cA + (size_t)(t + 2) * kstep; const char* b2 = last ? nB : cB + (size_t)(t + 2) * kstep;
            const char* a3 = a2 + kstep; const char* b3 = b2 + kstep;
            PG8_LDB(B0, 0, 0); PG8_LDB(B1, 0, 1); PG8_SCHED; PG8_LDA(At, 0, 0); PG8_STAGE(PG8_SA(1, 1), a1 + hstepA, voffA);
            PG8_WAIT_V(8); PG8_WAIT_L(0); PG8_BAR; PG8_MMA(0, 0, At, B0); PG8_MMA(0, 1, At, B1); PG8_BAR; PG8_SCHED;
            PG8_LDA(At, 0, 1); PG8_STAGE(PG8_SB(0, 0), b2, voffB); PG8_STAGE(PG8_SB(0, 1), b2 + hstepB, voffB); PG8_STAGE(PG8_SA(0, 0), a2, voffA);
            PG8_WAIT_V(8); PG8_WAIT_L(0); PG8_BAR; PG8_MMA(1, 0, At, B0); PG8_MMA(1, 1, At, B1); PG8_BAR; PG8_SCHED;
            PG8_LDB(B0, 1, 0); PG8_LDB(B1, 1, 1); PG8_SCHED; PG8_LDA(At, 1, 0); PG8_STAGE(PG8_SA(0, 1), a2 + hstepA, voffA);
            PG8_WAIT_V(8); PG8_WAIT_L(0); PG8_BAR; PG8_MMA(0, 0, At, B0); PG8_MMA(0, 1, At, B1); PG8_BAR; PG8_SCHED;
            PG8_LDA(At, 1, 1); PG8_STAGE(PG8_SB(1, 0), b3, voffB); PG8_STAGE(PG8_SB(1, 1), b3 + hstepB, voffB); PG8_STAGE(PG8_SA(1, 0), a3, voffA);
            PG8_WAIT_V(8); PG8_WAIT_L(0); PG8_BAR; PG8_MMA(1, 0, At, B0); PG8_MMA(1, 1, At, B1); PG8_BAR; PG8_SCHED;
        }
        if (wr == 0) PG8_BAR;
        { int fr_e = fr, fq_e = fq; asm volatile("" : "+v"(fr_e), "+v"(fq_e));
          E(acc, cur, wr, wc, fr_e, fq_e); }
        if (!has_next) break;
#pragma unroll
        for (int a = 0; a < 2; ++a)
#pragma unroll
            for (int b = 0; b < 2; ++b)
#pragma unroll
                for (int m = 0; m < 4; ++m)
#pragma unroll
                    for (int n = 0; n < 2; ++n) acc[a][b][m][n] = (f32x4){0.f, 0.f, 0.f, 0.f};
        cur = nxt; cA = nA; cB = nB; ++ui;
        if (wr == 1) PG8_BAR;
    }
    PG8_WAIT_V(0);
    PG8_BAR;
#undef PG8_SA
#undef PG8_SB
#undef PG8_ABASE
#undef PG8_STAGE
#undef PG8_LDA
#undef PG8_LDB
#undef PG8_MMA
#undef PG8_WAIT_V
#undef PG8_WAIT_L
#undef PG8_BAR
#undef PG8_SCHED
}

typedef f32x4 AccT[2][2][4][2];

struct EpiMain {
    static constexpr bool PERM = true;
    bf16_t* QK; bf16_t* V; bf16_t* O; float* gates; const float* b_gate;
    __device__ __forceinline__ void operator()(const AccT& acc, const Unit& u, int wr, int wc, int fr, int fq) const {
        const int row0 = u.pm * BM + wr * 64 + fr;
        if (u.pn < 6) {
            bf16_t* base = QK + (size_t)(u.pn >> 1) * (size_t)(16u << 20) + (u.pn & 1) * 256 + wc * 32 + 8 * fq;
#pragma unroll
            for (int ai = 0; ai < 2; ++ai)
#pragma unroll
                for (int m = 0; m < 4; ++m) { bf16_t* rowp = base + (size_t)(row0 + ai * HALF + m * 16) * 512;
#pragma unroll
                    for (int bj = 0; bj < 2; ++bj) { const f32x4 v0 = acc[ai][bj][m][0], v1 = acc[ai][bj][m][1];
                        u32x4 w; w.x = cvt_pk_bf16(v0[0], v0[1]); w.y = cvt_pk_bf16(v0[2], v0[3]); w.z = cvt_pk_bf16(v1[0], v1[1]); w.w = cvt_pk_bf16(v1[2], v1[3]);
                        *(u32x4*)(rowp + bj * HALF) = w; } }
        } else if (wc == 0 && fq < 2) {
#pragma unroll
            for (int n = 0; n < 2; ++n) { const int col = 8 * fq + 4 * n; const f32x4 bg = *(const f32x4*)(b_gate + col); const bool isf = (n == 1);
#pragma unroll
                for (int ai = 0; ai < 2; ++ai)
#pragma unroll
                    for (int m = 0; m < 4; ++m) { f32x4 v = acc[ai][0][m][n] + bg;
                        if (isf) { v[0] = log_sigmoid(v[0]); v[1] = log_sigmoid(v[1]); v[2] = log_sigmoid(v[2]); v[3] = log_sigmoid(v[3]); }
                        *(f32x4*)(gates + (size_t)(row0 + ai * HALF + m * 16) * 16 + col) = v; } }
        }
    }
};
struct EpiFF1 {
    static constexpr bool PERM = true;
    bf16_t* Hd; const float* bias;
    __device__ __forceinline__ void operator()(const AccT& acc, const Unit& u, int wr, int wc, int fr, int fq) const {
        const int row0 = u.pm * BM + wr * 64 + fr, col0 = u.pn * BM + wc * 32 + 8 * fq;
        f32x4 bv[2][2];
#pragma unroll
        for (int bj = 0; bj < 2; ++bj)
#pragma unroll
            for (int n = 0; n < 2; ++n) bv[bj][n] = *(const f32x4*)(bias + col0 + bj * HALF + 4 * n);
#pragma unroll
        for (int ai = 0; ai < 2; ++ai)
#pragma unroll
            for (int m = 0; m < 4; ++m) { bf16_t* rowp = Hd + (size_t)(row0 + ai * HALF + m * 16) * FF + col0;
#pragma unroll
                for (int bj = 0; bj < 2; ++bj) { f32x4 v0 = acc[ai][bj][m][0] + bv[bj][0], v1 = acc[ai][bj][m][1] + bv[bj][1];
#pragma unroll
                    for (int j = 0; j < 4; ++j) { const float a = fmaxf(v0[j], 0.f), b = fmaxf(v1[j], 0.f); v0[j] = a * a; v1[j] = b * b; }
                    u32x4 w; w.x = cvt_pk_bf16(v0[0], v0[1]); w.y = cvt_pk_bf16(v0[2], v0[3]); w.z = cvt_pk_bf16(v1[0], v1[1]); w.w = cvt_pk_bf16(v1[2], v1[3]);
                    *(u32x4*)(rowp + bj * HALF) = w; } }
    }
};
struct EpiOut {
    static constexpr bool PERM = true;
    const float* x; float* U; const float* mod;
    __device__ __forceinline__ void operator()(const AccT& acc, const Unit& u, int wr, int wc, int fr, int fq) const {
        const int row0 = u.pm * BM + wr * 64 + fr, col0 = u.pn * BM + wc * 32 + 8 * fq;
        const float* g1 = mod + (size_t)((u.pm * BM) >> 14) * 6144 + 2048 + col0;
        f32x4 gv[2][2];
#pragma unroll
        for (int bj = 0; bj < 2; ++bj)
#pragma unroll
            for (int n = 0; n < 2; ++n) gv[bj][n] = *(const f32x4*)(g1 + bj * HALF + 4 * n) + 1.0f;
#pragma unroll
        for (int ai = 0; ai < 2; ++ai)
#pragma unroll
            for (int m = 0; m < 4; ++m) { const size_t off = (size_t)(row0 + ai * HALF + m * 16) * DM + col0;
#pragma unroll
                for (int bj = 0; bj < 2; ++bj)
#pragma unroll
                    for (int n = 0; n < 2; ++n) { const f32x4 xv = *(const f32x4*)(x + off + bj * HALF + 4 * n);
                        *(f32x4*)(U + off + bj * HALF + 4 * n) = xv * ALPHA + gv[bj][n] * acc[ai][bj][m][n]; } }
    }
};
struct EpiFF2 {
    static constexpr bool PERM = true;
    float* U; const float* mod; const f32x2* st1; const float* ln_g; const float* ln_b; const float* b2;
    __device__ __forceinline__ void operator()(const AccT& acc, const Unit& u, int wr, int wc, int fr, int fq) const {
        const int row0 = u.pm * BM + wr * 64 + fr, col0 = u.pn * BM + wc * 32 + 8 * fq;
        const float* g2 = mod + (size_t)((u.pm * BM) >> 14) * 6144 + 5120 + col0;
#pragma unroll
        for (int bj = 0; bj < 2; ++bj)
#pragma unroll
            for (int n = 0; n < 2; ++n) { const int c = col0 + bj * HALF + 4 * n;
                const f32x4 gv = *(const f32x4*)(g2 + bj * HALF + 4 * n) + 1.0f, lg = *(const f32x4*)(ln_g + c), lb = *(const f32x4*)(ln_b + c), bb = *(const f32x4*)(b2 + c);
#pragma unroll
                for (int ai = 0; ai < 2; ++ai)
#pragma unroll
                    for (int m = 0; m < 4; ++m) { const int r = row0 + ai * HALF + m * 16; const f32x2 s = st1[r]; float* p = U + (size_t)r * DM + c;
                        const f32x4 uv = *(const f32x4*)p; const f32x4 x1 = (uv - s.x) * s.y * lg + lb;
                        *(f32x4*)p = x1 * ALPHA + gv * (acc[ai][bj][m][n] + bb); } }
    }
};
struct EpiFold {
    static constexpr bool PERM = true;
    bf16_t* WO;
    __device__ __forceinline__ void operator()(const AccT& acc, const Unit& u, int wr, int wc, int fr, int fq) const {
        const int g = u.pm >> 2, n0 = (u.pm & 3) * 256 + wr * 64 + fr;
        bf16_t* base = WO + 512 + g * 256 + wc * 32 + 8 * fq;
#pragma unroll
        for (int ai = 0; ai < 2; ++ai)
#pragma unroll
            for (int m = 0; m < 4; ++m) { bf16_t* rowp = base + (size_t)(n0 + ai * HALF + m * 16) * KOUT;
#pragma unroll
                for (int bj = 0; bj < 2; ++bj) { const f32x4 v0 = acc[ai][bj][m][0], v1 = acc[ai][bj][m][1];
                    u32x4 w; w.x = cvt_pk_bf16(v0[0], v0[1]); w.y = cvt_pk_bf16(v0[2], v0[3]); w.z = cvt_pk_bf16(v1[0], v1[1]); w.w = cvt_pk_bf16(v1[2], v1[3]);
                    *(u32x4*)(rowp + bj * HALF) = w; } }
    }
};
struct EpiF0 {
    static constexpr bool PERM = false;
    bf16_t* FZ;
    __device__ __forceinline__ void operator()(const AccT& acc, const Unit& u, int wr, int wc, int fr, int fq) const {
        const int b = u.pm >> 6, s20 = (u.pm & 63) * 2;
#pragma unroll
        for (int bj = 0; bj < 2; ++bj)
#pragma unroll
            for (int n = 0; n < 2; ++n) { const int c = u.pn * BM + bj * HALF + wc * 32 + n * 16 + fr;
#pragma unroll
                for (int ai = 0; ai < 2; ++ai)
#pragma unroll
                    for (int m = 0; m < 4; ++m) { const f32x4 v = acc[ai][bj][m][n];
                        u32x2 w; w.x = cvt_pk_bf16(v[0], v[1]); w.y = cvt_pk_bf16(v[2], v[3]);
                        *(u32x2*)(FZ + ((size_t)(b * 512 + c) * 128 + s20 + ai) * 128 + wr * 64 + m * 16 + 4 * fq) = w; } }
    }
};
struct EpiF1 {
    static constexpr bool PERM = false;
    bf16_t* F1O; const f32x2* TW;
    __device__ __forceinline__ void operator()(const AccT& acc, const Unit& u, int wr, int wc, int fr, int fq) const {
#pragma unroll
        for (int n = 0; n < 2; ++n) { const int k1 = wc * 32 + n * 16 + fr;
            const f32x2 w16 = TW[(16 * k1) & 16383];
            f32x2 t[4];
#pragma unroll
            for (int j = 0; j < 4; ++j) t[j] = TW[((wr * 64 + 4 * fq + j) * k1) & 16383];
#pragma unroll
            for (int m = 0; m < 4; ++m) { const int s2 = wr * 64 + m * 16 + 4 * fq;
#pragma unroll
                for (int ai = 0; ai < 2; ++ai) { const int bc = u.pm * 2 + ai, b = bc >> 9, c = bc & 511;
                    bf16_t* dst = F1O + (((size_t)(b * 128 + k1) * 512 + c) * 2) * 128;
                    const f32x4 ar = acc[ai][0][m][n], ai_ = acc[ai][1][m][n];
                    float pr[4], pi[4];
#pragma unroll
                    for (int j = 0; j < 4; ++j) { pr[j] = ar[j] * t[j].x + ai_[j] * t[j].y; pi[j] = ai_[j] * t[j].x - ar[j] * t[j].y; }
                    u32x2 w0, w1; w0.x = cvt_pk_bf16(pr[0], pr[1]); w0.y = cvt_pk_bf16(pr[2], pr[3]); w1.x = cvt_pk_bf16(pi[0], pi[1]); w1.y = cvt_pk_bf16(pi[2], pi[3]);
                    *(u32x2*)(dst + s2) = w0; *(u32x2*)(dst + 128 + s2) = w1; }
#pragma unroll
                for (int j = 0; j < 4; ++j) { const float c = t[j].x * w16.x - t[j].y * w16.y, s = t[j].y * w16.x + t[j].x * w16.y; t[j].x = c; t[j].y = s; }
                asm volatile("" ::: "memory"); } }
    }
};
struct EpiF2 {
    static constexpr bool PERM = false;
    bf16_t* AOUT;
    __device__ __forceinline__ void operator()(const AccT& acc, const Unit& u, int wr, int wc, int fr, int fq) const {
        const int bk = u.pm >> 1, chalf = u.pm & 1, b = bk >> 7, k1 = bk & 127;
#pragma unroll
        for (int bj = 0; bj < 2; ++bj)
#pragma unroll
            for (int n = 0; n < 2; ++n) { const int k2 = wc * 32 + n * 16 + fr; bf16_t* rowp = AOUT + (size_t)(b * SEQ + k1 + 128 * k2) * KOUT + 512 + bj * 128;
#pragma unroll
                for (int ai = 0; ai < 2; ++ai)
#pragma unroll
                    for (int m = 0; m < 4; ++m) { const f32x4 v = acc[ai][bj][m][n];
                        u32x2 w; w.x = cvt_pk_bf16(v[0], v[1]); w.y = cvt_pk_bf16(v[2], v[3]);
                        *(u32x2*)(rowp + (chalf * 2 + ai) * 256 + wr * 64 + m * 16 + 4 * fq) = w; } }
    }
};
}

#define XB_TMO      128
#define XB_XCNT(j)  (256  + 64 * (j))
#define XB_XSUB(j)  (1280 + 64 * (j))
#define XB_XGEN(j)  (2304 + 64 * (j))
#define XB_TOP      3328
#define XB_TOPGEN   3392
#define XCD_BAR_WORDS 3456
#define XB_SPIN_CAP (1u << 18)
__device__ __forceinline__ unsigned xb_ld(unsigned* p)              { return __hip_atomic_load(p, __ATOMIC_RELAXED, __HIP_MEMORY_SCOPE_AGENT); }
__device__ __forceinline__ unsigned xb_add(unsigned* p, unsigned v) { return __hip_atomic_fetch_add(p, v, __ATOMIC_RELAXED, __HIP_MEMORY_SCOPE_AGENT); }
__device__ __forceinline__ unsigned xb_xcc_id() { return (unsigned)__builtin_amdgcn_s_getreg((3 << 11) | 20) & 0xFu; }
#define XB_SPIN(cond, bar) do { unsigned _sp = 0; while (cond) { __builtin_amdgcn_s_sleep(1); \
    if ((++_sp & 255u) == 0u) { if (xb_ld(&(bar)[XB_TMO])) break; if (_sp > XB_SPIN_CAP) { atomicAdd(&(bar)[XB_TMO], 1u); break; } } } } while (0)
struct XcdBarrier { unsigned* bar; unsigned x; volatile LAS unsigned* st; };
__device__ __forceinline__ XcdBarrier xcd_barrier_post(unsigned* bar, volatile LAS unsigned* st) {
    XcdBarrier b; b.bar = bar; b.x = xb_xcc_id(); b.st = st;
    if (threadIdx.x == 0) (void)xb_add(&bar[XB_XCNT(b.x)], 1u);
    return b;
}
__device__ __forceinline__ void xcd_barrier_complete(unsigned* bar, unsigned x, unsigned& nloc, unsigned& nx) {
    const unsigned G = gridDim.x * gridDim.y * gridDim.z;
    unsigned sum, cnt, mine, sp = 0u;
    for (;;) {
        sum = 0u; cnt = 0u; mine = 0u;
#pragma unroll
        for (unsigned j = 0; j < 16; ++j) { const unsigned c = xb_ld(&bar[XB_XCNT(j)]); sum += c; cnt += (c > 0u) ? 1u : 0u; mine = (j == x) ? c : mine; }
        if (sum == G) break;
        __builtin_amdgcn_s_sleep(1);
        if ((++sp & 255u) == 0u) { if (xb_ld(&bar[XB_TMO])) break; if (sp > XB_SPIN_CAP) { atomicAdd(&bar[XB_TMO], 1u); break; } }
    }
    nloc = mine > 0u ? mine : 1u; nx = cnt > 0u ? cnt : 1u;
}
__device__ __forceinline__ void xcd_barrier(const XcdBarrier& b) {
    asm volatile("s_waitcnt vmcnt(0)" ::: "memory");
    __syncthreads();
    if (threadIdx.x == 0) {
        unsigned* bar = b.bar;
        __builtin_amdgcn_s_waitcnt(0);
        unsigned nloc = b.st[0], nx = b.st[1];
        if (nloc == 0u) { xcd_barrier_complete(bar, b.x, nloc, nx); b.st[0] = nloc; b.st[1] = nx; }
        const unsigned old = xb_add(&bar[XB_XSUB(b.x)], 1u);
        const unsigned gen = old / nloc;
        if (old + 1u == (gen + 1u) * nloc) {
            __builtin_amdgcn_fence(__ATOMIC_RELEASE, "agent");
            asm volatile("s_waitcnt vmcnt(0)" ::: "memory");
            const unsigned og = xb_add(&bar[XB_TOP], 1u);
            const unsigned tg = og / nx;
            if (og + 1u == (tg + 1u) * nx) xb_add(&bar[XB_TOPGEN], 1u);
            else XB_SPIN(xb_ld(&bar[XB_TOPGEN]) == tg, bar);
            __builtin_amdgcn_fence(__ATOMIC_ACQUIRE, "agent");
            xb_add(&bar[XB_XGEN(b.x)], 1u);
            asm volatile("s_waitcnt vmcnt(0)" ::: "memory");
        } else {
            XB_SPIN(xb_ld(&bar[XB_XGEN(b.x)]) == gen, bar);
            __builtin_amdgcn_fence(__ATOMIC_ACQUIRE, "agent");
            asm volatile("s_waitcnt vmcnt(0)" ::: "memory");
        }
    }
    __syncthreads();
}

__device__ __forceinline__ void p0_transpose_item(const float* W, int ldsrc, int col0, int nblk, bf16_t* WT, int ldk, int row_off, LAS float* scr, int item, int lane) {
    const int kb = item / nblk, nb = item % nblk, k0 = 64 * kb, n0 = 32 * nb;
#pragma unroll
    for (int i = 0; i < 32; ++i) { const int kk = 2 * i + (lane >> 5); scr[kk * 33 + (lane & 31)] = W[(size_t)(k0 + kk) * ldsrc + col0 + n0 + (lane & 31)]; }
    asm volatile("s_waitcnt lgkmcnt(0)" ::: "memory");
    const int c = lane & 7;
#pragma unroll
    for (int j = 0; j < 4; ++j) { const int n = (lane >> 3) + 8 * j; const LAS float* s = scr + (8 * c) * 33 + n;
        u32x4 o; o.x = pk2(s[0 * 33], s[1 * 33]); o.y = pk2(s[2 * 33], s[3 * 33]); o.z = pk2(s[4 * 33], s[5 * 33]); o.w = pk2(s[6 * 33], s[7 * 33]);
        *(u32x4*)(WT + (size_t)(row_off + n0 + n) * ldk + k0 + 8 * c) = o; }
    asm volatile("s_waitcnt lgkmcnt(0)" ::: "memory");
}

struct Args {
    const float* x; const float* c; const float* w_ada; const float* b_ada; const float* w_in; const float* b_gate; const float* norm_w; const float* w_out;
    const float* ln1_g; const float* ln1_b; const float* w_ff1; const float* b_ff1; const float* w_ff2; const float* b_ff2; const float* ln2_g; const float* ln2_b;
    float* out; unsigned char* ws; int ldw; int pad;
};

#ifndef PROBE_PH
#define PROBE_PH -1
#endif
#ifndef PROBE_HI
#define PROBE_HI (PROBE_PH + 1)
#endif
#define PROBE_MULT 8
#define STAMP(i) do { if (PROBE_PH >= 0 && blockIdx.x == 0 && threadIdx.x == 0) TS[i] = __builtin_amdgcn_s_memrealtime(); } while (0)
__global__ void __launch_bounds__(512, 2) fwd_kernel(Args a) {
    extern __shared__ __attribute__((aligned(16))) unsigned char lds_raw[];
    LAS unsigned char* lds = (LAS unsigned char*)lds_raw;
    cg::grid_group grid = cg::this_grid();
    const int G = gridDim.x, blk = blockIdx.x, NGW = G * 8, NGT = G * 512;
#define PHASE_IDS() int tid_l = threadIdx.x; asm volatile("" : "+v"(tid_l)); const int tid = tid_l, lane = tid & 63, wave = __builtin_amdgcn_readfirstlane(tid >> 6); \
    const int gw = blk * 8 + wave, gt = blk * 512 + tid; (void)gw; (void)gt; (void)lane; (void)NGW; (void)NGT
#define mod ((float*)(a.ws + WS_MOD))
#define TW ((f32x2*)(a.ws + WS_TW))
#define ST1 ((f32x2*)(a.ws + WS_ST1))
#define MIN ((float*)(a.ws + WS_MIN))
#define SC ((f32x2*)(a.ws + WS_SC))
#define B1 ((bf16_t*)(a.ws + WS_B1))
#define B2 ((bf16_t*)(a.ws + WS_B2))
#define B1F ((bf16_t*)(a.ws + WS_B1F))
#define WTMP ((bf16_t*)(a.ws + WS_WTMP))
#define TS ((unsigned long long*)(a.ws + WS_TS))
#define WCAT ((bf16_t*)(a.ws + WS_WCAT))
#define WOUT ((bf16_t*)(a.ws + WS_WOUT))
#define W1 ((bf16_t*)(a.ws + WS_W1))
#define W2 ((bf16_t*)(a.ws + WS_W2))
#define Hb ((bf16_t*)(a.ws + WS_H))
#define QK ((bf16_t*)(a.ws + WS_QK))
#define Vb ((bf16_t*)(a.ws + WS_V))
#define Ob ((bf16_t*)(a.ws + WS_O))
#define GATES ((float*)(a.ws + WS_GATES))
#define FZ ((bf16_t*)(a.ws + WS_FZ))
#define F1O ((bf16_t*)(a.ws + WS_F1O))
#define AOUT ((bf16_t*)(a.ws + WS_AOUT))
#define KVL ((float*)(a.ws + WS_KVL))
#define CST ((bf16_t*)(a.ws + WS_CST))
#define HID ((bf16_t*)(a.ws + WS_HID))
    const int ldw = a.ldw;

    STAMP(0);
    {
        PHASE_IDS();
        if (blk == 0) for (int i = tid; i < XCD_BAR_WORDS; i += 512) ((unsigned*)(a.ws + WS_BAR))[i] = 0u;
        if (tid < 4) ((LAS unsigned*)(lds + 143360))[tid] = 0u;
        if (blk < 192) {
            LAS float* sc = (LAS float*)lds;
            LAS float* red = (LAS float*)(lds + 8192);
            for (int i = tid; i < 2048; i += 512) { const float v = a.c[i]; sc[i] = v / (1.0f + expf(-v)); }
            __syncthreads();
            const int col = lane & 31, par = lane >> 5; float a0 = 0.f, a1 = 0.f;
            const float* wp = a.w_ada + (size_t)(wave * 128 + par) * 6144 + blk * 32 + col;
            float wv[64];
#pragma unroll
            for (int i = 0; i < 64; ++i) wv[i] = wp[(size_t)(2 * i) * 6144];
#pragma unroll
            for (int i = 0; i < 64; ++i) { const int k = wave * 128 + 2 * i + par; a0 += sc[k] * wv[i]; a1 += sc[1024 + k] * wv[i]; }
            a0 += __shfl_xor(a0, 32); a1 += __shfl_xor(a1, 32);
            if (par == 0) { red[(wave * 2 + 0) * 32 + col] = a0; red[(wave * 2 + 1) * 32 + col] = a1; }
            __syncthreads();
            if (tid < 64) { const int b = tid >> 5, l = tid & 31; float s = a.b_ada[blk * 32 + l];
#pragma unroll
                for (int w = 0; w < 8; ++w) s += red[(w * 2 + b) * 32 + l];
                mod[b * 6144 + blk * 32 + l] = s; }
        }
        __syncthreads();
        LAS float* scr = (LAS float*)(lds + wave * 16384);
        constexpr int I_A = 16 * 48, I_B = 16 * 16, I_C = 8 * 32, I_F = 8 * 32, I_D = 16 * 128, I_E = 64 * 32, NITEMS = I_A + I_B + I_C + I_F + I_D + I_E;
        for (int it = gw; it < NITEMS; it += NGW) {
            int r = it;
            if (r < I_A) { p0_transpose_item(a.w_in, ldw, 0, 48, WCAT, DM, 0, scr, r, lane); continue; } r -= I_A;
            if (r < I_B) { p0_transpose_item(a.w_in, ldw, 1536, 16, WCAT, DM, 1792, scr, r, lane); continue; } r -= I_B;
            if (r < I_C) { p0_transpose_item(a.w_out, DM, 0, 32, WOUT, KOUT, 0, scr, r, lane); continue; } r -= I_C;
            if (r < I_F) { p0_transpose_item(a.w_out + (size_t)512 * DM, DM, 0, 32, WTMP, 512, 0, scr, r, lane); continue; } r -= I_F;
            if (r < I_D) { p0_transpose_item(a.w_ff1, FF, 0, 128, W1, DM, 0, scr, r, lane); continue; } r -= I_D;
            p0_transpose_item(a.w_ff2, DM, 0, 32, W2, FF, 0, scr, r, lane);
        }
        for (int i = gt; i < 16 * 1024; i += NGT) { const int gcol = i >> 10, k = i & 1023; WCAT[(size_t)(1536 + gcol) * DM + k] = (bf16_t)f2bf(a.w_in[(size_t)k * ldw + 2048 + gcol]); }
        for (int i = gt; i < 240 * 128; i += NGT) *(u32x4*)(WCAT + (size_t)1552 * DM + (size_t)i * 8) = (u32x4){0u, 0u, 0u, 0u};
        const float isq = 0.08838834764831845f;
        for (int i = gt; i < 256 * 128; i += NGT) { const int n = i >> 7, s1 = i & 127, ri = n >> 7, k1 = n & 127; float s, c; sincospif((float)((k1 * s1) & 127) * (1.0f / 64.0f), &s, &c);
            B1[i] = (bf16_t)f2bf((ri ? -s : c) * isq); B1F[i] = (bf16_t)f2bf((ri ? s : c) * isq); }
        for (int i = gt; i < 256 * 256; i += NGT) { const int n = i >> 8, kk = i & 255, ro = n >> 7, k2 = n & 127, ri = kk >> 7, s2 = kk & 127; float s, c; sincospif((float)((k2 * s2) & 127) * (1.0f / 64.0f), &s, &c);
            const float v = (ro == 0) ? (ri == 0 ? c : s) : (ri == 0 ? -s : c); B2[i] = (bf16_t)f2bf(v * isq); }
        for (int i = gt; i < 16384; i += NGT) { float s, c; sincospif((float)i * (1.0f / 8192.0f), &s, &c); TW[i] = (f32x2){c, s}; }
    }
    grid.sync();
    const XcdBarrier xbar = xcd_barrier_post((unsigned*)(a.ws + WS_BAR), (volatile LAS unsigned*)(lds + 143360));
    STAMP(1);

    {
        pg8::Gemm g; g.A = WTMP; g.Bt = B1F; g.M = 4096; g.N = 256; g.K = 128; g.lda = 1024u; g.hstep = (size_t)128 * 1024; g.tdiv = 4; g.thi = 256; g.tlo = (size_t)256 * 1024;
        pg8::StaticOrder S; S.init(4096, 256, G, blk);
        pg8::EpiFold E{WOUT};
        pg8::gemm_phase<pg8::EpiFold, false>(lds, g, S, E);
    }
    { PHASE_IDS();
    for (int m0 = gw * 4; m0 < MT; m0 += NGW * 4) {
        f32x4 v[4][4];
#pragma unroll
        for (int r = 0; r < 4; ++r) { const f32x4* xr = (const f32x4*)(a.x + (size_t)(m0 + r) * DM) + lane;
#pragma unroll
            for (int j = 0; j < 4; ++j) v[r][j] = xr[64 * j]; }
        const float* mb = mod + (size_t)(m0 >> 14) * 6144;
#pragma unroll
        for (int r = 0; r < 4; ++r) {
            float s = 0.f;
#pragma unroll
            for (int j = 0; j < 4; ++j) s += (v[r][j][0] + v[r][j][1]) + (v[r][j][2] + v[r][j][3]);
            const float mean = wave_sum(s) * (1.f / DM); float s2 = 0.f;
#pragma unroll
            for (int j = 0; j < 4; ++j) { v[r][j] = v[r][j] - mean; s2 += (v[r][j][0] * v[r][j][0] + v[r][j][1] * v[r][j][1]) + (v[r][j][2] * v[r][j][2] + v[r][j][3] * v[r][j][3]); }
            const float rstd = 1.f / sqrtf(wave_sum(s2) * (1.f / DM) + LN_EPS);
            u32x2* o8 = (u32x2*)(Hb + (size_t)(m0 + r) * DM) + lane;
#pragma unroll
            for (int j = 0; j < 4; ++j) { const f32x4 sh = ((const f32x4*)mb)[lane + 64 * j], scv = ((const f32x4*)(mb + 1024))[lane + 64 * j] + 1.0f;
                const f32x4 y = v[r][j] * rstd * scv + sh; u32x2 w; w.x = pk2(y[0], y[1]); w.y = pk2(y[2], y[3]); o8[64 * j] = w; }
        }
    }
    }
    xcd_barrier(xbar);
    STAMP(2);

    {
        pg8::Gemm g; g.A = Hb; g.Bt = WCAT + (size_t)1792 * DM; g.M = MT; g.N = 512; g.K = DM; g.lda = 128u * DM * 2u; g.hstep = (size_t)DM * 2; g.tdiv = 64; g.thi = (size_t)SEQ * DM * 2; g.tlo = (size_t)2 * DM * 2;
        pg8::StaticOrder S; S.init(MT, 512, G, blk);
        pg8::EpiF0 E{FZ};
        pg8::gemm_phase<pg8::EpiF0, true>(lds, g, S, E);
    }
    {
        pg8::Gemm g = pg8::std_gemm(Hb, WCAT, MT, 1792, DM);
        pg8::StaticOrder S; S.init(MT, 1792, G, blk);
        pg8::EpiMain E{QK, Vb, Ob, GATES, a.b_gate};
        pg8::gemm_phase<pg8::EpiMain, false>(lds, g, S, E);
    }
    xcd_barrier(xbar);
    STAMP(3);

    {
        pg8::Gemm g = pg8::std_gemm(FZ, B1, NB * 512 * 128, 256, 128);
        pg8::StaticOrder S; S.init(NB * 512 * 128, 256, G, blk);
        pg8::EpiF1 E{F1O, TW};
        pg8::gemm_phase<pg8::EpiF1, true>(lds, g, S, E);
    }
    {
        PHASE_IDS();
        LAS bf16_t* KsT = (LAS bf16_t*)lds;
        LAS bf16_t* VT = (LAS bf16_t*)(lds + 34816);
        LAS float* gl = (LAS float*)(lds + 69632);
        LAS float* gg = (LAS float*)(lds + 69632 + 2048);
        LAS float* wk = (LAS float*)(lds + 69632 + 3072);
        const int fr = lane & 15, fq = lane >> 4;
        for (int u = blk; u < NB * NH * NCHUNK; u += G) {
            const int chunk = u & 127, h = (u >> 7) & 3, b = u >> 9; const size_t tok0 = (size_t)b * SEQ + chunk * 128;
            const int chain_f = (b * NH + h) * 2;
            __syncthreads();
            if (tid < 128) {
#pragma unroll
                for (int ty = 0; ty < 4; ++ty) gl[ty * 128 + tid] = GATES[(tok0 + tid) * 16 + ty * 4 + h];
            }
            __syncthreads();
            if (tid < 128) {
                float bf_ = 0.f, totf = 0.f, br_ = 0.f, totb = 0.f;
                for (int r = 0; r < 128; ++r) { const float f = gl[128 + r], fb = gl[384 + r]; totf += f; totb += fb; bf_ += (r <= tid) ? f : 0.f; br_ += (r >= tid) ? fb : 0.f; }
                gg[tid] = totf - bf_ + gl[tid]; gg[128 + tid] = totb - br_ + gl[256 + tid];
                if (tid == 0) { wk[0] = totf; wk[1] = totb; }
            }
            __syncthreads();
            float mlf = -3.0e38f, mlb = -3.0e38f;
            if (tid < 128) {
                for (int r = 0; r < 128; ++r) { mlf = fmaxf(mlf, gg[r]); mlb = fmaxf(mlb, gg[128 + r]); }
                if (tid == 0) { SC[(size_t)chain_f * 128 + chunk] = (f32x2){wk[0], mlf}; SC[(size_t)(chain_f + 1) * 128 + chunk] = (f32x2){wk[1], mlb}; }
            }
            __syncthreads();
            if (tid < 128) { wk[tid] = expf(gg[tid] - mlf); wk[128 + tid] = expf(gg[128 + tid] - mlb); }
            __syncthreads();
            {
                const int s = tid >> 2, q4 = tid & 3; const float wf = wk[s], wb = wk[128 + s];
                const bf16_t* kp = QK + (tok0 + s) * 512 + 256 + h * 64 + q4 * 16;
                const bf16x8 k0 = *(const bf16x8*)kp, k1 = *(const bf16x8*)(kp + 8);
#pragma unroll
                for (int j = 0; j < 8; ++j) { const float a0 = bf2f((unsigned short)k0[j]), a1 = bf2f((unsigned short)k1[j]); const int d0 = q4 * 16 + j, d1 = d0 + 8;
                    KsT[d0 * 136 + s] = (bf16_t)f2bf(a0 * wf); KsT[d1 * 136 + s] = (bf16_t)f2bf(a1 * wf);
                    KsT[(64 + d0) * 136 + s] = (bf16_t)f2bf(a0 * wb); KsT[(64 + d1) * 136 + s] = (bf16_t)f2bf(a1 * wb); }
                const bf16_t* vp = Vb + (tok0 + s) * 512 + h * 128 + q4 * 32;
#pragma unroll
                for (int c = 0; c < 4; ++c) { const bf16x8 vv = *(const bf16x8*)(vp + c * 8);
#pragma unroll
                    for (int j = 0; j < 8; ++j) VT[(q4 * 32 + c * 8 + j) * 136 + s] = (bf16_t)vv[j]; }
            }
            __syncthreads();
            {
                f32x4 acc[8];
#pragma unroll
                for (int n = 0; n < 8; ++n) acc[n] = (f32x4){0.f, 0.f, 0.f, 0.f};
#pragma unroll
                for (int ks = 0; ks < 4; ++ks) { const bf16x8 af = *(const LAS bf16x8*)(KsT + (wave * 16 + fr) * 136 + ks * 32 + fq * 8);
#pragma unroll
                    for (int n = 0; n < 8; ++n) { const bf16x8 bfv = *(const LAS bf16x8*)(VT + (n * 16 + fr) * 136 + ks * 32 + fq * 8);
                        acc[n] = __builtin_amdgcn_mfma_f32_16x16x32_bf16(af, bfv, acc[n], 0, 0, 0); } }
                const int dir = wave >> 2, d = (wave & 3) * 16 + 4 * fq;
                float* dst = KVL + ((size_t)(chain_f + dir) * 128 + chunk) * ST_ROW;
#pragma unroll
                for (int n = 0; n < 8; ++n) *(f32x4*)(dst + (n * 16 + fr) * 64 + d) = acc[n];
                if (tid < 128) { float s = 0.f; for (int r = 0; r < 128; ++r) s += bf2f(KsT[tid * 136 + r]);
                    KVL[((size_t)(chain_f + (tid >> 6)) * 128 + chunk) * ST_ROW + 128 * 64 + (tid & 63)] = s; }
            }
        }
        __syncthreads();
    }
    xcd_barrier(xbar);
    STAMP(4);

    { PHASE_IDS();
    if (gt < 16 * (ST_ROW / 2)) {
        const int chain = gt / (ST_ROW / 2), p = gt % (ST_ROW / 2), dir = chain & 1;
        const float* src = KVL + (size_t)chain * 128 * ST_ROW + 2 * p; bf16_t* dst = CST + (size_t)chain * 128 * ST_ROW + 2 * p;
        const f32x2* scp = SC + (size_t)chain * 128; float* mo = MIN + chain * 128;
        float c0 = 0.f, c1 = 0.f, m = 0.f;
        for (int i0 = 0; i0 < 128; i0 += 8) {
            f32x2 kv[8], sc[8];
#pragma unroll
            for (int q = 0; q < 8; ++q) { const int j = dir ? 127 - (i0 + q) : (i0 + q); kv[q] = *(const f32x2*)(src + (size_t)j * ST_ROW); sc[q] = scp[j]; }
#pragma unroll
            for (int q = 0; q < 8; ++q) { const int j = dir ? 127 - (i0 + q) : (i0 + q);
                *(unsigned*)(dst + (size_t)j * ST_ROW) = pk2(c0, c1); if (p == 0) mo[j] = m;
                const float mn = fmaxf(sc[q].x + m, sc[q].y), dec = expf(sc[q].x + m - mn), wl = expf(sc[q].y - mn);
                c0 = dec * c0 + wl * kv[q].x; c1 = dec * c1 + wl * kv[q].y; m = mn; }
        }
    }
    }
    {
        pg8::Gemm g = pg8::std_gemm(F1O, B2, NB * 128 * 512, 256, 256);
        pg8::StaticOrder S; S.init(NB * 128 * 512, 256, G, blk);
        pg8::EpiF2 E{AOUT};
        pg8::gemm_phase<pg8::EpiF2, true>(lds, g, S, E);
    }
    xcd_barrier(xbar);
    STAMP(5);

    {
        PHASE_IDS();
        LAS bf16_t* Kx = (LAS bf16_t*)lds;
        LAS bf16_t* VT = (LAS bf16_t*)(lds + 20736);
        LAS bf16_t* CfT = (LAS bf16_t*)(lds + 55552);
        LAS bf16_t* CbT = (LAS bf16_t*)(lds + 73984);
        LAS float* gl = (LAS float*)(lds + 92416);
        LAS float* sa = (LAS float*)(lds + 92416 + 2048);
        LAS float* sr = (LAS float*)(lds + 92416 + 4096);
        const int fr = lane & 15, fq = lane >> 4;
        for (int u = blk; u < NB * NH * NCHUNK; u += G) {
            const int h = u & 3, chunk = (u >> 2) & 127, b = u >> 9; const size_t tok0 = (size_t)b * SEQ + chunk * 128;
            const int chain_f = (b * NH + h) * 2;
            const bf16_t* cf = CST + ((size_t)chain_f * 128 + chunk) * ST_ROW; const bf16_t* cb = CST + ((size_t)(chain_f + 1) * 128 + chunk) * ST_ROW;
            __syncthreads();
            if (tid < 128) {
#pragma unroll
                for (int ty = 0; ty < 4; ++ty) gl[ty * 128 + tid] = GATES[(tok0 + tid) * 16 + ty * 4 + h];
            }
            {
#pragma unroll
                for (int i = 0; i < 2; ++i) { const int c = tid + i * 512, s = c >> 3, part = c & 7;
                    *(LAS u32x4*)(Kx + s * 72 + part * 8) = *(const u32x4*)(QK + (tok0 + s) * 512 + 256 + h * 64 + part * 8);
                    *(LAS u32x4*)(CfT + s * 72 + part * 8) = *(const u32x4*)(cf + s * 64 + part * 8);
                    *(LAS u32x4*)(CbT + s * 72 + part * 8) = *(const u32x4*)(cb + s * 64 + part * 8); }
                if (tid < 16) { const int r = tid >> 3, part = tid & 7; *(LAS u32x4*)(Kx + (128 + r) * 72 + part * 8) = *(const u32x4*)((r ? cb : cf) + 128 * 64 + part * 8); }
                else if (tid >= 64 && tid < 64 + 14 * 9) { const int c = tid - 64; *(LAS u32x4*)(Kx + 130 * 72 + c * 8) = (u32x4){0u, 0u, 0u, 0u}; }
                const int s = tid >> 2, q4 = tid & 3;
                const bf16_t* vp = Vb + (tok0 + s) * 512 + h * 128 + q4 * 32;
#pragma unroll
                for (int c = 0; c < 4; ++c) { const bf16x8 vv = *(const bf16x8*)(vp + c * 8);
#pragma unroll
                    for (int j = 0; j < 8; ++j) VT[(q4 * 32 + c * 8 + j) * 136 + s] = (bf16_t)vv[j]; }
            }
            __syncthreads();
            const float m_f = MIN[chain_f * 128 + chunk], m_b = MIN[(chain_f + 1) * 128 + chunk];
            if (tid < 128) {
                float bf_ = 0.f, br_ = 0.f;
                for (int r = 0; r < 128; ++r) { const float f = gl[128 + r], fb = gl[384 + r]; bf_ += (r <= tid) ? f : 0.f; br_ += (r >= tid) ? fb : 0.f; }
                sa[tid] = gl[tid] - bf_; sa[128 + tid] = gl[256 + tid] - br_; sa[256 + tid] = bf_; sa[384 + tid] = br_;
            }
            __syncthreads();
            if (tid < 128) {
                float Mf = m_f, Mb = m_b;
                for (int r = 0; r < 128; ++r) { const float x0 = sa[r], x1 = sa[128 + r]; Mf = (r <= tid) ? fmaxf(Mf, x0) : Mf; Mb = (r >= tid) ? fmaxf(Mb, x1) : Mb; }
                sr[tid] = Mf; sr[128 + tid] = Mb; sr[256 + tid] = expf(m_f - Mf); sr[384 + tid] = expf(m_b - Mb);
                sr[512 + tid] = expf(-sa[256 + tid] - Mf); sr[640 + tid] = expf(-sa[384 + tid] - Mb);
            }
            __syncthreads();
            {
                const int t = wave * 16 + fr;
                const bf16_t* qp = QK + (tok0 + t) * 512 + h * 64 + fq * 8;
                const bf16x8 q0 = *(const bf16x8*)qp, q1 = *(const bf16x8*)(qp + 32);
                f32x4 sacc[9];
#pragma unroll
                for (int n = 0; n < 9; ++n) { sacc[n] = (f32x4){0.f, 0.f, 0.f, 0.f};
                    const bf16x8 kf0 = *(const LAS bf16x8*)(Kx + (n * 16 + fr) * 72 + fq * 8), kf1 = *(const LAS bf16x8*)(Kx + (n * 16 + fr) * 72 + 32 + fq * 8);
                    sacc[n] = __builtin_amdgcn_mfma_f32_16x16x32_bf16(kf0, q0, sacc[n], 0, 0, 0);
                    sacc[n] = __builtin_amdgcn_mfma_f32_16x16x32_bf16(kf1, q1, sacc[n], 0, 0, 0); }
                const float qnf = __shfl(sacc[8][0], fr), qnb = __shfl(sacc[8][1], fr);
                const float Mf = sr[t], Mb = sr[128 + t], wif = sr[256 + t], wib = sr[384 + t], flf = sr[512 + t], flb = sr[640 + t];
                float pf[8][4], pb[8][4]; float sumf = 0.f, sumb = 0.f;
#pragma unroll
                for (int n = 0; n < 8; ++n)
#pragma unroll
                    for (int j = 0; j < 4; ++j) { const int s = n * 16 + 4 * fq + j; const float sv = sacc[n][j] * 0.125f;
                        const float wf = (s <= t) ? expf(sa[s] - Mf) : 0.f, wb = (s >= t) ? expf(sa[128 + s] - Mb) : 0.f;
                        pf[n][j] = sv * wf; pb[n][j] = sv * wb; sumf += pf[n][j]; sumb += pb[n][j]; }
                sumf += __shfl_xor(sumf, 16); sumf += __shfl_xor(sumf, 32); sumb += __shfl_xor(sumb, 16); sumb += __shfl_xor(sumb, 32);
                const float denf = sumf + wif * 0.125f * qnf, denb = sumb + wib * 0.125f * qnb;
                const float rf = 1.0f / fmaxf(fabsf(denf), flf), rb = 1.0f / fmaxf(fabsf(denb), flb);
                bf16x8 pfr[4], qaf[2], qab[2];
#pragma unroll
                for (int ks = 0; ks < 4; ++ks) { u32x4 w;
                    w.x = pk2(pf[2 * ks][0] * rf + pb[2 * ks][0] * rb, pf[2 * ks][1] * rf + pb[2 * ks][1] * rb); w.y = pk2(pf[2 * ks][2] * rf + pb[2 * ks][2] * rb, pf[2 * ks][3] * rf + pb[2 * ks][3] * rb);
                    w.z = pk2(pf[2 * ks + 1][0] * rf + pb[2 * ks + 1][0] * rb, pf[2 * ks + 1][1] * rf + pb[2 * ks + 1][1] * rb); w.w = pk2(pf[2 * ks + 1][2] * rf + pb[2 * ks + 1][2] * rb, pf[2 * ks + 1][3] * rf + pb[2 * ks + 1][3] * rb);
                    pfr[ks] = __builtin_bit_cast(bf16x8, w); }
                const float cfw = 0.125f * rf * wif, cbw = 0.125f * rb * wib;
#pragma unroll
                for (int ks = 0; ks < 2; ++ks) { const bf16x8 qv = ks ? q1 : q0; u32x4 wfv, wbv; unsigned tf[4], tb[4];
#pragma unroll
                    for (int j = 0; j < 4; ++j) { const float e0 = bf2f((unsigned short)qv[2 * j]), e1 = bf2f((unsigned short)qv[2 * j + 1]); tf[j] = pk2(e0 * cfw, e1 * cfw); tb[j] = pk2(e0 * cbw, e1 * cbw); }
                    wfv = (u32x4){tf[0], tf[1], tf[2], tf[3]}; wbv = (u32x4){tb[0], tb[1], tb[2], tb[3]};
                    qaf[ks] = __builtin_bit_cast(bf16x8, wfv); qab[ks] = __builtin_bit_cast(bf16x8, wbv); }
                f32x4 oacc[8];
#pragma unroll
                for (int ne = 0; ne < 8; ++ne) { oacc[ne] = (f32x4){0.f, 0.f, 0.f, 0.f}; const int e = ne * 16 + fr;
#pragma unroll
                    for (int ks = 0; ks < 4; ++ks) { const bf16x4 lo = *(const LAS bf16x4*)(VT + e * 136 + ks * 32 + 4 * fq), hi = *(const LAS bf16x4*)(VT + e * 136 + ks * 32 + 16 + 4 * fq);
                        const bf16x8 vf = (bf16x8){lo[0], lo[1], lo[2], lo[3], hi[0], hi[1], hi[2], hi[3]};
                        oacc[ne] = __builtin_amdgcn_mfma_f32_16x16x32_bf16(vf, pfr[ks], oacc[ne], 0, 0, 0); }
#pragma unroll
                    for (int ks = 0; ks < 2; ++ks) { const bf16x8 c1 = *(const LAS bf16x8*)(CfT + e * 72 + ks * 32 + fq * 8), c2 = *(const LAS bf16x8*)(CbT + e * 72 + ks * 32 + fq * 8);
                        oacc[ne] = __builtin_amdgcn_mfma_f32_16x16x32_bf16(c1, qaf[ks], oacc[ne], 0, 0, 0);
                        oacc[ne] = __builtin_amdgcn_mfma_f32_16x16x32_bf16(c2, qab[ks], oacc[ne], 0, 0, 0); } }
                float s1 = 0.f;
#pragma unroll
                for (int ne = 0; ne < 8; ++ne) s1 += (oacc[ne][0] + oacc[ne][1]) + (oacc[ne][2] + oacc[ne][3]);
                s1 += __shfl_xor(s1, 16); s1 += __shfl_xor(s1, 32);
                const float mu = s1 * (1.0f / 128.0f); float s2 = 0.f;
#pragma unroll
                for (int ne = 0; ne < 8; ++ne) { oacc[ne] = oacc[ne] - mu; s2 += (oacc[ne][0] * oacc[ne][0] + oacc[ne][1] * oacc[ne][1]) + (oacc[ne][2] * oacc[ne][2] + oacc[ne][3] * oacc[ne][3]); }
                s2 += __shfl_xor(s2, 16); s2 += __shfl_xor(s2, 32);
                const float rstd = 1.0f / sqrtf(s2 * (1.0f / 128.0f) + LN_EPS);
                const bf16_t* op = Ob + (tok0 + t) * 512 + h * 128 + 4 * fq; bf16_t* yp = AOUT + (tok0 + t) * KOUT + h * 128 + 4 * fq; const float* nw = a.norm_w + h * 128 + 4 * fq;
#pragma unroll
                for (int ne = 0; ne < 8; ++ne) { const bf16x4 ov = *(const bf16x4*)(op + ne * 16); const f32x4 wv = *(const f32x4*)(nw + ne * 16); float y[4];
#pragma unroll
                    for (int j = 0; j < 4; ++j) { const float og = bf2f((unsigned short)ov[j]); y[j] = oacc[ne][j] * rstd * wv[j] / (1.0f + expf(-og)); }
                    u32x2 w; w.x = pk2(y[0], y[1]); w.y = pk2(y[2], y[3]); *(u32x2*)(yp + ne * 16) = w; }
            }
        }
        __syncthreads();
    }
    xcd_barrier(xbar);
    STAMP(6);

    {
        pg8::Gemm g = pg8::std_gemm(AOUT, WOUT, MT, DM, KOUT);
        pg8::StaticOrder S; S.init(MT, DM, G, blk);
        pg8::EpiOut E{a.x, a.out, mod};
        pg8::gemm_phase<pg8::EpiOut, false>(lds, g, S, E);
    }
    xcd_barrier(xbar);
    STAMP(7);

    { PHASE_IDS();
    for (int m0 = gw * 4; m0 < MT; m0 += NGW * 4) {
        f32x4 v[4][4];
#pragma unroll
        for (int r = 0; r < 4; ++r) { const f32x4* ur = (const f32x4*)(a.out + (size_t)(m0 + r) * DM) + lane;
#pragma unroll
            for (int j = 0; j < 4; ++j) v[r][j] = ur[64 * j]; }
        const float* mb = mod + (size_t)(m0 >> 14) * 6144;
#pragma unroll
        for (int r = 0; r < 4; ++r) {
            float s = 0.f;
#pragma unroll
            for (int j = 0; j < 4; ++j) s += (v[r][j][0] + v[r][j][1]) + (v[r][j][2] + v[r][j][3]);
            const float mean = wave_sum(s) * (1.f / DM); float s2 = 0.f;
#pragma unroll
            for (int j = 0; j < 4; ++j) { v[r][j] = v[r][j] - mean; s2 += (v[r][j][0] * v[r][j][0] + v[r][j][1] * v[r][j][1]) + (v[r][j][2] * v[r][j][2] + v[r][j][3] * v[r][j][3]); }
            const float rstd = 1.f / sqrtf(wave_sum(s2) * (1.f / DM) + LN_EPS);
            if (lane == 0) ST1[m0 + r] = (f32x2){mean, rstd};
            float t = 0.f;
#pragma unroll
            for (int j = 0; j < 4; ++j) { const f32x4 lg = ((const f32x4*)a.ln1_g)[lane + 64 * j], lb = ((const f32x4*)a.ln1_b)[lane + 64 * j]; v[r][j] = v[r][j] * rstd * lg + lb; t += (v[r][j][0] + v[r][j][1]) + (v[r][j][2] + v[r][j][3]); }
            const float mean2 = wave_sum(t) * (1.f / DM); float t2 = 0.f;
#pragma unroll
            for (int j = 0; j < 4; ++j) { v[r][j] = v[r][j] - mean2; t2 += (v[r][j][0] * v[r][j][0] + v[r][j][1] * v[r][j][1]) + (v[r][j][2] * v[r][j][2] + v[r][j][3] * v[r][j][3]); }
            const float rstd2 = 1.f / sqrtf(wave_sum(t2) * (1.f / DM) + LN_EPS);
            u32x2* o8 = (u32x2*)(Hb + (size_t)(m0 + r) * DM) + lane;
#pragma unroll
            for (int j = 0; j < 4; ++j) { const f32x4 sh = ((const f32x4*)(mb + 3072))[lane + 64 * j], scv = ((const f32x4*)(mb + 4096))[lane + 64 * j] + 1.0f;
                const f32x4 y = v[r][j] * rstd2 * scv + sh; u32x2 w; w.x = pk2(y[0], y[1]); w.y = pk2(y[2], y[3]); o8[64 * j] = w; }
        }
    }
    }
    xcd_barrier(xbar);
    STAMP(8);

    {
        pg8::Gemm g = pg8::std_gemm(Hb, W1, MT, FF, DM);
        pg8::StaticOrder S; S.init(MT, FF, G, blk);
        pg8::EpiFF1 E{HID, a.b_ff1};
        pg8::gemm_phase<pg8::EpiFF1, false>(lds, g, S, E);
    }
    xcd_barrier(xbar);
    STAMP(9);

    {
        pg8::Gemm g = pg8::std_gemm(HID, W2, MT, DM, FF);
        pg8::StaticOrder S; S.init(MT, DM, G, blk);
        pg8::EpiFF2 E{a.out, mod, ST1, a.ln1_g, a.ln1_b, a.b_ff2};
        pg8::gemm_phase<pg8::EpiFF2, false>(lds, g, S, E);
    }
    xcd_barrier(xbar);
    STAMP(10);

    { PHASE_IDS();
    for (int m0 = gw * 4; m0 < MT; m0 += NGW * 4) {
        f32x4 v[4][4];
#pragma unroll
        for (int r = 0; r < 4; ++r) { const f32x4* ur = (const f32x4*)(a.out + (size_t)(m0 + r) * DM) + lane;
#pragma unroll
            for (int j = 0; j < 4; ++j) v[r][j] = ur[64 * j]; }
#pragma unroll
        for (int r = 0; r < 4; ++r) {
            float s = 0.f;
#pragma unroll
            for (int j = 0; j < 4; ++j) s += (v[r][j][0] + v[r][j][1]) + (v[r][j][2] + v[r][j][3]);
            const float mean = wave_sum(s) * (1.f / DM); float s2 = 0.f;
#pragma unroll
            for (int j = 0; j < 4; ++j) { v[r][j] = v[r][j] - mean; s2 += (v[r][j][0] * v[r][j][0] + v[r][j][1] * v[r][j][1]) + (v[r][j][2] * v[r][j][2] + v[r][j][3] * v[r][j][3]); }
            const float rstd = 1.f / sqrtf(wave_sum(s2) * (1.f / DM) + LN_EPS);
            f32x4* orow = (f32x4*)(a.out + (size_t)(m0 + r) * DM) + lane;
#pragma unroll
            for (int j = 0; j < 4; ++j) { const f32x4 lg = ((const f32x4*)a.ln2_g)[lane + 64 * j], lb = ((const f32x4*)a.ln2_b)[lane + 64 * j]; orow[64 * j] = v[r][j] * rstd * lg + lb; }
        }
    }
    }
    if (PROBE_PH >= 0 && blockIdx.x == 0 && threadIdx.x == 0) {
        const unsigned long long t1 = __builtin_amdgcn_s_memrealtime(); TS[11] = t1;
        const unsigned long long span = (TS[PROBE_HI] - TS[PROBE_PH]) * PROBE_MULT;
        while (__builtin_amdgcn_s_memrealtime() - t1 < span) __builtin_amdgcn_s_sleep(8);
    }
}

extern "C" void kernel_launch(void* const* d_in, const int* in_sizes, int n_in, void* d_out, int out_size, void* d_ws, size_t ws_size, hipStream_t stream) {
    static int grid = 0;
    if (grid == 0) {
        if (n_in != 16 || out_size != MT * DM || ws_size < WS_END) { fprintf(stderr, "kernel_launch: unexpected shapes (n_in %d, out %d, ws %zu)\n", n_in, out_size, ws_size); grid = -1; return; }
        int dev = 0, cus = 0, per_cu = 0;
        hipGetDevice(&dev);
        hipDeviceGetAttribute(&cus, hipDeviceAttributeMultiprocessorCount, dev);
        hipFuncSetAttribute((const void*)fwd_kernel, hipFuncAttributeMaxDynamicSharedMemorySize, LDS_BYTES);
        hipOccupancyMaxActiveBlocksPerMultiprocessor(&per_cu, (const void*)fwd_kernel, 512, LDS_BYTES);
        if (per_cu < 1) per_cu = 1;
        grid = cus * per_cu;
        if (grid > 256) grid = 256;
        (void)hipGetLastError();
    }
    if (grid < 0) return;
    Args a{};
    a.x = (const float*)d_in[0]; a.c = (const float*)d_in[1]; a.w_ada = (const float*)d_in[2]; a.b_ada = (const float*)d_in[3]; a.w_in = (const float*)d_in[4];
    a.b_gate = (const float*)d_in[5]; a.norm_w = (const float*)d_in[6]; a.w_out = (const float*)d_in[7]; a.ln1_g = (const float*)d_in[8]; a.ln1_b = (const float*)d_in[9];
    a.w_ff1 = (const float*)d_in[10]; a.b_ff1 = (const float*)d_in[11]; a.w_ff2 = (const float*)d_in[12]; a.b_ff2 = (const float*)d_in[13]; a.ln2_g = (const float*)d_in[14]; a.ln2_b = (const float*)d_in[15];
    a.out = (float*)d_out; a.ws = (unsigned char*)d_ws; a.ldw = in_sizes[4] / DM; a.pad = 0;
    void* args[] = {&a};
    hipError_t e = hipLaunchCooperativeKernel((const void*)fwd_kernel, dim3(grid), dim3(512), args, LDS_BYTES, stream);
    if (e != hipSuccess) fprintf(stderr, "cooperative launch failed: %s (grid %d)\n", hipGetErrorString(e), grid);
}
```

```cpp
#include <hip/hip_runtime.h>
#include <hip/hip_cooperative_groups.h>
#include <cstdio>
#include <cstdint>
namespace cg = cooperative_groups;

#define LAS __attribute__((address_space(3)))
typedef unsigned short bf16_t;
typedef short bf16x8 __attribute__((ext_vector_type(8)));
typedef short bf16x4 __attribute__((ext_vector_type(4)));
typedef float f32x4 __attribute__((ext_vector_type(4)));
typedef float f32x2 __attribute__((ext_vector_type(2)));
typedef unsigned u32x4 __attribute__((ext_vector_type(4)));
typedef unsigned u32x2 __attribute__((ext_vector_type(2)));

constexpr int NB = 2, SEQ = 16384, DM = 1024, MT = NB * SEQ, FF = 4096, NH = 4;
constexpr int NCHUNK = 128;
constexpr int NCAT = 2304;
constexpr int KOUT = 1536;
constexpr float LN_EPS = 1e-5f;
constexpr float ALPHA = 1.189207115002721f;
constexpr int ST_ROW = 129 * 64;

constexpr size_t KiB = 1024, MiB = 1u << 20;
constexpr size_t WS_MOD = 0, WS_TW = 64 * KiB, WS_ST1 = 192 * KiB, WS_MIN = 448 * KiB, WS_SC = 456 * KiB, WS_B1 = 512 * KiB, WS_B2 = 576 * KiB;
constexpr size_t WS_SCAL = 26 * MiB;
constexpr size_t WS_B1F = 704 * KiB, WS_TS = 768 * KiB, WS_BAR = 832 * KiB, WS_WTMP = 25 * MiB;
constexpr size_t WS_WCAT = 1 * MiB, WS_WOUT = 6 * MiB, WS_W1 = 9 * MiB, WS_W2 = 17 * MiB;
constexpr size_t WS_H = 32 * MiB;
constexpr size_t WS_QK = 96 * MiB, WS_V = 128 * MiB, WS_O = 160 * MiB, WS_GATES = 192 * MiB, WS_FZ = 194 * MiB, WS_F1O = 226 * MiB, WS_AOUT = 290 * MiB,
                 WS_KVL = 386 * MiB, WS_CST = 452 * MiB, WS_END = 486 * MiB;
constexpr size_t WS_U16 = 386 * MiB;
constexpr size_t WS_HID = 96 * MiB;
constexpr int LDS_BYTES = 147456;

__device__ __forceinline__ unsigned f2bf(float f) { unsigned u = __builtin_bit_cast(unsigned, f); return (u + 0x7fffu + ((u >> 16) & 1u)) >> 16; }
__device__ __forceinline__ unsigned pk2(float lo, float hi) { return f2bf(lo) | (f2bf(hi) << 16); }
__device__ __forceinline__ float bf2f(unsigned short h) { return __builtin_bit_cast(float, (unsigned)h << 16); }
__device__ __forceinline__ float wave_sum(float v) {
#pragma unroll
    for (int o = 1; o < 64; o <<= 1) v += __shfl_xor(v, o);
    return v;
}
__device__ __forceinline__ void wave_sum8(float (&s)[8]) {
#pragma unroll
    for (int o = 1; o < 64; o <<= 1) {
        float t[8];
#pragma unroll
        for (int i = 0; i < 8; ++i) t[i] = __shfl_xor(s[i], o);
#pragma unroll
        for (int i = 0; i < 8; ++i) s[i] += t[i];
    }
}
#define LN_LOAD4(dst, base, m0_) do { _Pragma("unroll") for (int r = 0; r < 4; ++r) { const f32x4* p_ = (const f32x4*)((base) + (size_t)((m0_) + r) * DM) + lane; \
        _Pragma("unroll") for (int j = 0; j < 4; ++j) dst[r][j] = p_[64 * j]; } } while (0)
#define LN_LOAD4_BF16(dst, base, m0_) do { _Pragma("unroll") for (int r = 0; r < 4; ++r) { const bf16_t* p_ = (base) + (size_t)((m0_) + r) * DM + 8 * lane; \
        _Pragma("unroll") for (int hf = 0; hf < 2; ++hf) { const u32x4 w_ = *(const u32x4*)(p_ + hf * 512); \
            dst[r][2 * hf][0] = __builtin_bit_cast(float, w_.x << 16); dst[r][2 * hf][1] = __builtin_bit_cast(float, w_.x & 0xffff0000u); dst[r][2 * hf][2] = __builtin_bit_cast(float, w_.y << 16); dst[r][2 * hf][3] = __builtin_bit_cast(float, w_.y & 0xffff0000u); \
            dst[r][2 * hf + 1][0] = __builtin_bit_cast(float, w_.z << 16); dst[r][2 * hf + 1][1] = __builtin_bit_cast(float, w_.z & 0xffff0000u); dst[r][2 * hf + 1][2] = __builtin_bit_cast(float, w_.w << 16); dst[r][2 * hf + 1][3] = __builtin_bit_cast(float, w_.w & 0xffff0000u); } } } while (0)
#define LN_PARAM(p, j) (*(const f32x4*)((p) + ((j) >> 1) * 512 + 8 * lane + 4 * ((j) & 1)))
#define LN_STATS4(v, sq) do { _Pragma("unroll") for (int r = 0; r < 4; ++r) { float s_ = 0.f, q_ = 0.f; \
        _Pragma("unroll") for (int j = 0; j < 4; ++j) { s_ += (v[r][j][0] + v[r][j][1]) + (v[r][j][2] + v[r][j][3]); \
            q_ += (v[r][j][0] * v[r][j][0] + v[r][j][1] * v[r][j][1]) + (v[r][j][2] * v[r][j][2] + v[r][j][3] * v[r][j][3]); } \
        sq[r] = s_; sq[4 + r] = q_; } wave_sum8(sq); \
        _Pragma("unroll") for (int r = 0; r < 4; ++r) { const float mean_ = sq[r] * (1.f / DM); const float var_ = fmaxf(sq[4 + r] * (1.f / DM) - mean_ * mean_, 0.f); sq[r] = mean_; sq[4 + r] = 1.f / sqrtf(var_ + LN_EPS); } } while (0)
__device__ __forceinline__ float log_sigmoid(float x) { return fminf(x, 0.f) - __logf(1.0f + __expf(-fabsf(x))); }

namespace pg8 {
constexpr int BM = 256, BK = 64, HALF = 128, HTB = HALF * BK * 2, STAGE_BYTES = 8 * HTB, NXCD = 8, WGM = 8;
__host__ __device__ __forceinline__ int lds_byte(int r, int c) { const int st = (r >> 4) * 2 + (c >> 5), rr = r & 15, cc = c & 31, ob = rr * 64 + cc * 2; return st * 1024 + (ob ^ (((ob >> 9) & 1) << 5)); }
__host__ __device__ __forceinline__ void stage_rc(int b, int& R, int& C) { const int st = b / 1024, sb = b % 1024, swz = sb ^ (((sb >> 9) & 1) << 5); R = (st >> 1) * 16 + swz / 64; C = (st & 1) * 32 + (swz % 64) / 2; }
__host__ __device__ __forceinline__ int perm32(int rho) { const int n = rho >> 4, i = rho & 15; return 8 * (i >> 2) + 4 * n + (i & 3); }

struct Unit { int pm, pn; };
struct Gemm { const bf16_t* A; const bf16_t* Bt; int M, N, K; unsigned lda; size_t hstep; int tdiv; size_t thi, tlo; };
__device__ __forceinline__ Gemm std_gemm(const bf16_t* A, const bf16_t* Bt, int M, int N, int K) {
    Gemm g; g.A = A; g.Bt = Bt; g.M = M; g.N = N; g.K = K; g.lda = (unsigned)K * 2u; g.hstep = (size_t)HALF * K * 2; g.tdiv = 1 << 30; g.thi = 0; g.tlo = (size_t)BM * K * 2; return g;
}

struct StaticOrder {
    int nM, nN, nwg, G, c;
    __device__ void init(int M, int N, int G_, int c_) { nM = M / BM; nN = N / BM; nwg = nM * nN; G = G_; c = c_; }
    __device__ bool next(int i, Unit& u) const {
        const long L = (long)i * G + c; if (L >= nwg) return false;
        int wgid = (int)L; { const int q = nwg / NXCD, r = nwg % NXCD, xcd = wgid % NXCD, off = wgid / NXCD; wgid = (xcd < r ? xcd * (q + 1) : r * (q + 1) + (xcd - r) * q) + off; }
        const int nig = WGM * nN, gid = wgid / nig, fm = gid * WGM, gsz = (nM - fm) < WGM ? (nM - fm) : WGM;
        u.pm = fm + ((wgid % nig) % gsz); u.pn = (wgid % nig) / gsz; return true;
    }
};

__device__ __forceinline__ unsigned cvt_pk_bf16(float lo, float hi) { unsigned r; asm volatile("v_cvt_pk_bf16_f32 %0, %1, %2" : "=v"(r) : "v"(lo), "v"(hi)); return r; }

template <class Epi, bool SWAP>
__device__ __forceinline__ void gemm_phase(LAS unsigned char* lds, const Gemm g, const StaticOrder& S, const Epi& E) {
    int tid_ = threadIdx.x; asm volatile("" : "+v"(tid_));
    const int tid = tid_, wid = __builtin_amdgcn_readfirstlane(tid >> 6), lane = tid & 63, wr = wid >> 2, wc = wid & 3, fr = lane & 15, fq = lane >> 4;
    const int K = g.K, nt = K / BK;
    unsigned voffA[2], voffB[2];
#pragma unroll
    for (int i = 0; i < 2; ++i) { int R, C; stage_rc(tid * 16 + i * 8192, R, C); const int Rb = (Epi::PERM && !SWAP) ? ((R & ~31) + perm32(R & 31)) : R;
        voffA[i] = (unsigned)R * g.lda + (unsigned)C * 2u; voffB[i] = (unsigned)(Rb * K + C) * 2u; }
    const size_t kstep = (size_t)(BK * 2);
    const size_t hstepA = g.hstep;
    const size_t hstepB = (size_t)HALF * K * 2, tstepB = 2 * hstepB;
    const unsigned ldsw = (unsigned)wid * 1024u;
    const int aoff = lds_byte(wr * 64 + fr, fq * 8), boff = lds_byte(wc * 32 + fr, fq * 8);
#define PG8_SA(b, h) (((b) * 2 + (h)) * HTB)
#define PG8_SB(b, h) ((4 + (b) * 2 + (h)) * HTB)
#define PG8_ABASE(pm) ((const char*)g.A + (size_t)((pm) / g.tdiv) * g.thi + (size_t)((pm) % g.tdiv) * g.tlo)
#define PG8_STAGE(bufoff, gbase, voff) do { _Pragma("unroll") for (int _i = 0; _i < 2; ++_i) \
        __builtin_amdgcn_global_load_lds((const unsigned*)((const char*)(gbase) + (voff)[_i]), (LAS unsigned*)(lds + (bufoff) + ldsw + _i * 8192), 16, 0, 0); } while (0)
#define PG8_LDA(dst, b, h) do { _Pragma("unroll") for (int m = 0; m < 4; ++m) _Pragma("unroll") for (int k = 0; k < 2; ++k) dst[m][k] = *(const LAS bf16x8*)(lds + PG8_SA(b, h) + aoff + m * 2048 + k * 1024); } while (0)
#define PG8_LDB(dst, b, h) do { _Pragma("unroll") for (int n = 0; n < 2; ++n) _Pragma("unroll") for (int k = 0; k < 2; ++k) dst[n][k] = *(const LAS bf16x8*)(lds + PG8_SB(b, h) + boff + n * 2048 + k * 1024); } while (0)
#define PG8_MMA(ai, bj, At, Bt) do { __builtin_amdgcn_s_setprio(1); _Pragma("unroll") for (int m = 0; m < 4; ++m) _Pragma("unroll") for (int n = 0; n < 2; ++n) _Pragma("unroll") for (int k = 0; k < 2; ++k) \
        acc[ai][bj][m][n] = SWAP ? __builtin_amdgcn_mfma_f32_16x16x32_bf16(At[m][k], Bt[n][k], acc[ai][bj][m][n], 0, 0, 0) \
                                 : __builtin_amdgcn_mfma_f32_16x16x32_bf16(Bt[n][k], At[m][k], acc[ai][bj][m][n], 0, 0, 0); __builtin_amdgcn_s_setprio(0); } while (0)
#define PG8_WAIT_V(n) asm volatile("s_waitcnt vmcnt(" #n ")" ::: "memory")
#define PG8_WAIT_L(n) asm volatile("s_waitcnt lgkmcnt(" #n ")" ::: "memory")
#define PG8_BAR __builtin_amdgcn_s_barrier()
#define PG8_SCHED __builtin_amdgcn_sched_barrier(0)
    Unit cur, nxt; int ui = 0;
    if (!S.next(0, cur)) return;
    f32x4 acc[2][2][4][2];
#pragma unroll
    for (int a = 0; a < 2; ++a)
#pragma unroll
        for (int b = 0; b < 2; ++b)
#pragma unroll
            for (int m = 0; m < 4; ++m)
#pragma unroll
                for (int n = 0; n < 2; ++n) acc[a][b][m][n] = (f32x4){0.f, 0.f, 0.f, 0.f};
    bf16x8 At[4][2], B0[2][2], B1[2][2];
    const char* cA = PG8_ABASE(cur.pm); const char* cB = (const char*)g.Bt + (size_t)cur.pn * tstepB;
    PG8_STAGE(PG8_SB(0, 0), cB, voffB); PG8_STAGE(PG8_SB(0, 1), cB + hstepB, voffB); PG8_STAGE(PG8_SA(0, 0), cA, voffA); PG8_STAGE(PG8_SA(0, 1), cA + hstepA, voffA);
    if (wr == 1) PG8_BAR;
    PG8_WAIT_V(2); PG8_BAR;
    PG8_STAGE(PG8_SB(1, 0), cB + kstep, voffB); PG8_STAGE(PG8_SA(1, 0), cA + kstep, voffA); PG8_STAGE(PG8_SB(1, 1), cB + hstepB + kstep, voffB);
    PG8_WAIT_V(6); PG8_BAR;
    for (;;) {
        const bool has_next = S.next(ui + 1, nxt);
        const char* nA = has_next ? PG8_ABASE(nxt.pm) : cA; const char* nB = has_next ? (const char*)g.Bt + (size_t)nxt.pn * tstepB : cB;
        for (int t = 0; t < nt; t += 2) {
            const bool last = (t == nt - 2);
            const char* a1 = cA + (size_t)(t + 1) * kstep;
            const char* a2 = last ? nA : cA + (size_t)(t + 2) * kstep; const char* b2 = last ? nB : cB + (size_t)(t + 2) * kstep;
            const char* a3 = a2 + kstep; const char* b3 = b2 + kstep;
            PG8_LDB(B0, 0, 0); PG8_LDB(B1, 0, 1); PG8_SCHED; PG8_LDA(At, 0, 0); PG8_STAGE(PG8_SA(1, 1), a1 + hstepA, voffA);
            PG8_WAIT_V(8); PG8_WAIT_L(0); PG8_BAR; PG8_MMA(0, 0, At, B0); PG8_MMA(0, 1, At, B1); PG8_BAR; PG8_SCHED;
            PG8_LDA(At, 0, 1); PG8_STAGE(PG8_SB(0, 0), b2, voffB); PG8_STAGE(PG8_SB(0, 1), b2 + hstepB, voffB); PG8_STAGE(PG8_SA(0, 0), a2, voffA);
            PG8_WAIT_V(8); PG8_WAIT_L(0); PG8_BAR; PG8_MMA(1, 0, At, B0); PG8_MMA(1, 1, At, B1); PG8_BAR; PG8_SCHED;
            PG8_LDB(B0, 1, 0); PG8_LDB(B1, 1, 1); PG8_SCHED; PG8_LDA(At, 1, 0); PG8_STAGE(PG8_SA(0, 1), a2 + hstepA, voffA);
            PG8_WAIT_V(8); PG8_WAIT_L(0); PG8_BAR; PG8_MMA(0, 0, At, B0); PG8_MMA(0, 1, At, B1); PG8_BAR; PG8_SCHED;
            PG8_LDA(At, 1, 1); PG8_STAGE(PG8_SB(1, 0), b3, voffB); PG8_STAGE(PG8_SB(1, 1), b3 + hstepB, voffB); PG8_STAGE(PG8_SA(1, 0), a3, voffA);
            PG8_WAIT_V(8); PG8_WAIT_L(0); PG8_BAR; PG8_MMA(1, 0, At, B0); PG8_MMA(1, 1, At, B1); PG8_BAR; PG8_SCHED;
        }
        if (wr == 0) PG8_BAR;
        { int fr_e = fr, fq_e = fq; asm volatile("" : "+v"(fr_e), "+v"(fq_e));
          E(acc, cur, wr, wc, fr_e, fq_e); }
        if (!has_next) break;
#pragma unroll
        for (int a = 0; a < 2; ++a)
#pragma unroll
            for (int b = 0; b < 2; ++b)
#pragma unroll
                for (int m = 0; m < 4; ++m)
#pragma unroll
                    for (int n = 0; n < 2; ++n) acc[a][b][m][n] = (f32x4){0.f, 0.f, 0.f, 0.f};
        cur = nxt; cA = nA; cB = nB; ++ui;
        if (wr == 1) PG8_BAR;
    }
    PG8_WAIT_V(0);
    PG8_BAR;
#undef PG8_SA
#undef PG8_SB
#undef PG8_ABASE
#undef PG8_STAGE
#undef PG8_LDA
#undef PG8_LDB
#undef PG8_MMA
#undef PG8_WAIT_V
#undef PG8_WAIT_L
#undef PG8_BAR
#undef PG8_SCHED
}

typedef f32x4 AccT[2][2][4][2];

struct EpiMain {
    static constexpr bool PERM = true;
    bf16_t* QK; bf16_t* V; bf16_t* O; float* gates; const float* b_gate;
    __device__ __forceinline__ void operator()(const AccT& acc, const Unit& u, int wr, int wc, int fr, int fq) const {
        const int row0 = u.pm * BM + wr * 64 + fr;
        if (u.pn < 6) {
            bf16_t* base = QK + (size_t)(u.pn >> 1) * (size_t)(16u << 20) + (u.pn & 1) * 256 + wc * 32 + 8 * fq;
#pragma unroll
            for (int ai = 0; ai < 2; ++ai)
#pragma unroll
                for (int m = 0; m < 4; ++m) { bf16_t* rowp = base + (size_t)(row0 + ai * HALF + m * 16) * 512;
#pragma unroll
                    for (int bj = 0; bj < 2; ++bj) { const f32x4 v0 = acc[ai][bj][m][0], v1 = acc[ai][bj][m][1];
                        u32x4 w; w.x = cvt_pk_bf16(v0[0], v0[1]); w.y = cvt_pk_bf16(v0[2], v0[3]); w.z = cvt_pk_bf16(v1[0], v1[1]); w.w = cvt_pk_bf16(v1[2], v1[3]);
                        *(u32x4*)(rowp + bj * HALF) = w; } }
        } else if (wc == 0 && fq < 2) {
#pragma unroll
            for (int n = 0; n < 2; ++n) { const int col = 8 * fq + 4 * n; const f32x4 bg = *(const f32x4*)(b_gate + col); const bool isf = (n == 1);
#pragma unroll
                for (int ai = 0; ai < 2; ++ai)
#pragma unroll
                    for (int m = 0; m < 4; ++m) { f32x4 v = acc[ai][0][m][n] + bg;
                        if (isf) { v[0] = log_sigmoid(v[0]); v[1] = log_sigmoid(v[1]); v[2] = log_sigmoid(v[2]); v[3] = log_sigmoid(v[3]); }
                        *(f32x4*)(gates + (size_t)(row0 + ai * HALF + m * 16) * 16 + col) = v; } }
        }
    }
};
struct EpiFF1 {
    static constexpr bool PERM = true;
    bf16_t* Hd; const float* bias;
    __device__ __forceinline__ void operator()(const AccT& acc, const Unit& u, int wr, int wc, int fr, int fq) const {
        const int row0 = u.pm * BM + wr * 64 + fr, col0 = u.pn * BM + wc * 32 + 8 * fq;
        f32x4 bv[2][2];
#pragma unroll
        for (int bj = 0; bj < 2; ++bj)
#pragma unroll
            for (int n = 0; n < 2; ++n) bv[bj][n] = *(const f32x4*)(bias + col0 + bj * HALF + 4 * n);
#pragma unroll
        for (int ai = 0; ai < 2; ++ai)
#pragma unroll
            for (int m = 0; m < 4; ++m) { bf16_t* rowp = Hd + (size_t)(row0 + ai * HALF + m * 16) * FF + col0;
#pragma unroll
                for (int bj = 0; bj < 2; ++bj) { f32x4 v0 = acc[ai][bj][m][0] + bv[bj][0], v1 = acc[ai][bj][m][1] + bv[bj][1];
#pragma unroll
                    for (int j = 0; j < 4; ++j) { const float a = fmaxf(v0[j], 0.f), b = fmaxf(v1[j], 0.f); v0[j] = a * a; v1[j] = b * b; }
                    u32x4 w; w.x = cvt_pk_bf16(v0[0], v0[1]); w.y = cvt_pk_bf16(v0[2], v0[3]); w.z = cvt_pk_bf16(v1[0], v1[1]); w.w = cvt_pk_bf16(v1[2], v1[3]);
                    *(u32x4*)(rowp + bj * HALF) = w; } }
    }
};
struct EpiOut {
    static constexpr bool PERM = true;
    const float* x; bf16_t* U; const float* mod;
    __device__ __forceinline__ void operator()(const AccT& acc, const Unit& u, int wr, int wc, int fr, int fq) const {
        const int row0 = u.pm * BM + wr * 64 + fr, col0 = u.pn * BM + wc * 32 + 8 * fq;
        const float* g1 = mod + (size_t)((u.pm * BM) >> 14) * 6144 + 2048 + col0;
        f32x4 gv[2][2];
#pragma unroll
        for (int bj = 0; bj < 2; ++bj)
#pragma unroll
            for (int n = 0; n < 2; ++n) gv[bj][n] = *(const f32x4*)(g1 + bj * HALF + 4 * n) + 1.0f;
#pragma unroll
        for (int ai = 0; ai < 2; ++ai)
#pragma unroll
            for (int m = 0; m < 4; ++m) { const size_t off = (size_t)(row0 + ai * HALF + m * 16) * DM + col0;
#pragma unroll
                for (int bj = 0; bj < 2; ++bj) { const f32x4 x0 = *(const f32x4*)(x + off + bj * HALF), x1 = *(const f32x4*)(x + off + bj * HALF + 4);
                    const f32x4 v0 = x0 * ALPHA + gv[bj][0] * acc[ai][bj][m][0], v1 = x1 * ALPHA + gv[bj][1] * acc[ai][bj][m][1];
                    u32x4 w; w.x = cvt_pk_bf16(v0[0], v0[1]); w.y = cvt_pk_bf16(v0[2], v0[3]); w.z = cvt_pk_bf16(v1[0], v1[1]); w.w = cvt_pk_bf16(v1[2], v1[3]);
                    *(u32x4*)(U + off + bj * HALF) = w; } }
    }
};
struct EpiFF2 {
    static constexpr bool PERM = true;
    const bf16_t* U; bf16_t* V; const float* mod; const f32x2* st1; const float* ln_g; const float* ln_b; const float* b2;
    __device__ __forceinline__ void operator()(const AccT& acc, const Unit& u, int wr, int wc, int fr, int fq) const {
        const int row0 = u.pm * BM + wr * 64 + fr, col0 = u.pn * BM + wc * 32 + 8 * fq;
        const float* g2 = mod + (size_t)((u.pm * BM) >> 14) * 6144 + 5120 + col0;
#pragma unroll
        for (int bj = 0; bj < 2; ++bj) { const int c = col0 + bj * HALF;
            const f32x4 gv0 = *(const f32x4*)(g2 + bj * HALF) + 1.0f, gv1 = *(const f32x4*)(g2 + bj * HALF + 4) + 1.0f, lg0 = *(const f32x4*)(ln_g + c), lg1 = *(const f32x4*)(ln_g + c + 4),
                        lb0 = *(const f32x4*)(ln_b + c), lb1 = *(const f32x4*)(ln_b + c + 4), bb0 = *(const f32x4*)(b2 + c), bb1 = *(const f32x4*)(b2 + c + 4);
#pragma unroll
            for (int ai = 0; ai < 2; ++ai)
#pragma unroll
                for (int m = 0; m < 4; ++m) { const int r = row0 + ai * HALF + m * 16; const f32x2 s = st1[r]; const size_t off = (size_t)r * DM + c;
                    const u32x4 uw = *(const u32x4*)(U + off);
                    f32x4 u0, u1;
                    u0[0] = __builtin_bit_cast(float, uw.x << 16); u0[1] = __builtin_bit_cast(float, uw.x & 0xffff0000u); u0[2] = __builtin_bit_cast(float, uw.y << 16); u0[3] = __builtin_bit_cast(float, uw.y & 0xffff0000u);
                    u1[0] = __builtin_bit_cast(float, uw.z << 16); u1[1] = __builtin_bit_cast(float, uw.z & 0xffff0000u); u1[2] = __builtin_bit_cast(float, uw.w << 16); u1[3] = __builtin_bit_cast(float, uw.w & 0xffff0000u);
                    const f32x4 xa = (u0 - s.x) * s.y * lg0 + lb0, xb = (u1 - s.x) * s.y * lg1 + lb1;
                    const f32x4 v0 = xa * ALPHA + gv0 * (acc[ai][bj][m][0] + bb0), v1 = xb * ALPHA + gv1 * (acc[ai][bj][m][1] + bb1);
                    u32x4 w; w.x = cvt_pk_bf16(v0[0], v0[1]); w.y = cvt_pk_bf16(v0[2], v0[3]); w.z = cvt_pk_bf16(v1[0], v1[1]); w.w = cvt_pk_bf16(v1[2], v1[3]);
                    *(u32x4*)(V + off) = w; } }
    }
};
struct EpiFold {
    static constexpr bool PERM = true;
    bf16_t* WO;
    __device__ __forceinline__ void operator()(const AccT& acc, const Unit& u, int wr, int wc, int fr, int fq) const {
        const int g = u.pm >> 2, n0 = (u.pm & 3) * 256 + wr * 64 + fr;
        bf16_t* base = WO + 512 + g * 256 + wc * 32 + 8 * fq;
#pragma unroll
        for (int ai = 0; ai < 2; ++ai)
#pragma unroll
            for (int m = 0; m < 4; ++m) { bf16_t* rowp = base + (size_t)(n0 + ai * HALF + m * 16) * KOUT;
#pragma unroll
                for (int bj = 0; bj < 2; ++bj) { const f32x4 v0 = acc[ai][bj][m][0], v1 = acc[ai][bj][m][1];
                    u32x4 w; w.x = cvt_pk_bf16(v0[0], v0[1]); w.y = cvt_pk_bf16(v0[2], v0[3]); w.z = cvt_pk_bf16(v1[0], v1[1]); w.w = cvt_pk_bf16(v1[2], v1[3]);
                    *(u32x4*)(rowp + bj * HALF) = w; } }
    }
};
struct EpiF0 {
    static constexpr bool PERM = false;
    bf16_t* FZ;
    __device__ __forceinline__ void operator()(const AccT& acc, const Unit& u, int wr, int wc, int fr, int fq) const {
        const int b = u.pm >> 6, s20 = (u.pm & 63) * 2;
#pragma unroll
        for (int bj = 0; bj < 2; ++bj)
#pragma unroll
            for (int n = 0; n < 2; ++n) { const int c = u.pn * BM + bj * HALF + wc * 32 + n * 16 + fr;
#pragma unroll
                for (int ai = 0; ai < 2; ++ai)
#pragma unroll
                    for (int m = 0; m < 4; ++m) { const f32x4 v = acc[ai][bj][m][n];
                        u32x2 w; w.x = cvt_pk_bf16(v[0], v[1]); w.y = cvt_pk_bf16(v[2], v[3]);
                        *(u32x2*)(FZ + ((size_t)(b * 512 + c) * 128 + s20 + ai) * 128 + wr * 64 + m * 16 + 4 * fq) = w; } }
    }
};
struct EpiF1 {
    static constexpr bool PERM = false;
    bf16_t* F1O; const f32x2* TW;
    __device__ __forceinline__ void operator()(const AccT& acc, const Unit& u, int wr, int wc, int fr, int fq) const {
#pragma unroll
        for (int n = 0; n < 2; ++n) { const int k1 = wc * 32 + n * 16 + fr;
            const f32x2 w16 = TW[(16 * k1) & 16383];
            f32x2 t[4];
#pragma unroll
            for (int j = 0; j < 4; ++j) t[j] = TW[((wr * 64 + 4 * fq + j) * k1) & 16383];
#pragma unroll
            for (int m = 0; m < 4; ++m) { const int s2 = wr * 64 + m * 16 + 4 * fq;
#pragma unroll
                for (int ai = 0; ai < 2; ++ai) { const int bc = u.pm * 2 + ai, b = bc >> 9, c = bc & 511;
                    bf16_t* dst = F1O + (((size_t)(b * 128 + k1) * 512 + c) * 2) * 128;
                    const f32x4 ar = acc[ai][0][m][n], ai_ = acc[ai][1][m][n];
                    float pr[4], pi[4];
#pragma unroll
                    for (int j = 0; j < 4; ++j) { pr[j] = ar[j] * t[j].x + ai_[j] * t[j].y; pi[j] = ai_[j] * t[j].x - ar[j] * t[j].y; }
                    u32x2 w0, w1; w0.x = cvt_pk_bf16(pr[0], pr[1]); w0.y = cvt_pk_bf16(pr[2], pr[3]); w1.x = cvt_pk_bf16(pi[0], pi[1]); w1.y = cvt_pk_bf16(pi[2], pi[3]);
                    *(u32x2*)(dst + s2) = w0; *(u32x2*)(dst + 128 + s2) = w1; }
#pragma unroll
                for (int j = 0; j < 4; ++j) { const float c = t[j].x * w16.x - t[j].y * w16.y, s = t[j].y * w16.x + t[j].x * w16.y; t[j].x = c; t[j].y = s; }
                asm volatile("" ::: "memory"); } }
    }
};
struct EpiF2 {
    static constexpr bool PERM = false;
    bf16_t* AOUT;
    __device__ __forceinline__ void operator()(const AccT& acc, const Unit& u, int wr, int wc, int fr, int fq) const {
        const int bk = u.pm >> 1, chalf = u.pm & 1, b = bk >> 7, k1 = bk & 127;
#pragma unroll
        for (int bj = 0; bj < 2; ++bj)
#pragma unroll
            for (int n = 0; n < 2; ++n) { const int k2 = wc * 32 + n * 16 + fr; bf16_t* rowp = AOUT + (size_t)(b * SEQ + k1 + 128 * k2) * KOUT + 512 + bj * 128;
#pragma unroll
                for (int ai = 0; ai < 2; ++ai)
#pragma unroll
                    for (int m = 0; m < 4; ++m) { const f32x4 v = acc[ai][bj][m][n];
                        u32x2 w; w.x = cvt_pk_bf16(v[0], v[1]); w.y = cvt_pk_bf16(v[2], v[3]);
                        *(u32x2*)(rowp + (chalf * 2 + ai) * 256 + wr * 64 + m * 16 + 4 * fq) = w; } }
    }
};
}

#define XB_TMO      128
#define XB_XCNT(j)  (256  + 64 * (j))
#define XB_XSUB(j)  (1280 + 64 * (j))
#define XB_XGEN(j)  (2304 + 64 * (j))
#define XB_TOP      3328
#define XB_TOPGEN   3392
#define XCD_BAR_WORDS 3456
#define XB_SPIN_CAP (1u << 18)
__device__ __forceinline__ unsigned xb_ld(unsigned* p)              { return __hip_atomic_load(p, __ATOMIC_RELAXED, __HIP_MEMORY_SCOPE_AGENT); }
__device__ __forceinline__ unsigned xb_add(unsigned* p, unsigned v) { return __hip_atomic_fetch_add(p, v, __ATOMIC_RELAXED, __HIP_MEMORY_SCOPE_AGENT); }
__device__ __forceinline__ unsigned xb_xcc_id() { return (unsigned)__builtin_amdgcn_s_getreg((3 << 11) | 20) & 0xFu; }
#define XB_SPIN(cond, bar) do { unsigned _sp = 0; while (cond) { __builtin_amdgcn_s_sleep(1); \
    if ((++_sp & 255u) == 0u) { if (xb_ld(&(bar)[XB_TMO])) break; if (_sp > XB_SPIN_CAP) { atomicAdd(&(bar)[XB_TMO], 1u); break; } } } } while (0)
struct XcdBarrier { unsigned* bar; unsigned x; volatile LAS unsigned* st; };
__device__ __forceinline__ XcdBarrier xcd_barrier_post(unsigned* bar, volatile LAS unsigned* st) {
    XcdBarrier b; b.bar = bar; b.x = xb_xcc_id(); b.st = st;
    if (threadIdx.x == 0) (void)xb_add(&bar[XB_XCNT(b.x)], 1u);
    return b;
}
__device__ __forceinline__ void xcd_barrier_complete(unsigned* bar, unsigned x, unsigned& nloc, unsigned& nx) {
    const unsigned G = gridDim.x * gridDim.y * gridDim.z;
    unsigned sum, cnt, mine, sp = 0u;
    for (;;) {
        sum = 0u; cnt = 0u; mine = 0u;
#pragma unroll
        for (unsigned j = 0; j < 16; ++j) { const unsigned c = xb_ld(&bar[XB_XCNT(j)]); sum += c; cnt += (c > 0u) ? 1u : 0u; mine = (j == x) ? c : mine; }
        if (sum == G) break;
        __builtin_amdgcn_s_sleep(1);
        if ((++sp & 255u) == 0u) { if (xb_ld(&bar[XB_TMO])) break; if (sp > XB_SPIN_CAP) { atomicAdd(&bar[XB_TMO], 1u); break; } }
    }
    nloc = mine > 0u ? mine : 1u; nx = cnt > 0u ? cnt : 1u;
}
__device__ __forceinline__ void xcd_barrier(const XcdBarrier& b) {
    asm volatile("s_waitcnt vmcnt(0)" ::: "memory");
    __syncthreads();
    if (threadIdx.x == 0) {
        unsigned* bar = b.bar;
        __builtin_amdgcn_s_waitcnt(0);
        unsigned nloc = b.st[0], nx = b.st[1];
        if (nloc == 0u) { xcd_barrier_complete(bar, b.x, nloc, nx); b.st[0] = nloc; b.st[1] = nx; }
        const unsigned old = xb_add(&bar[XB_XSUB(b.x)], 1u);
        const unsigned gen = old / nloc;
        if (old + 1u == (gen + 1u) * nloc) {
            __builtin_amdgcn_fence(__ATOMIC_RELEASE, "agent");
            asm volatile("s_waitcnt vmcnt(0)" ::: "memory");
            const unsigned og = xb_add(&bar[XB_TOP], 1u);
            const unsigned tg = og / nx;
            if (og + 1u == (tg + 1u) * nx) xb_add(&bar[XB_TOPGEN], 1u);
            else XB_SPIN(xb_ld(&bar[XB_TOPGEN]) == tg, bar);
            __builtin_amdgcn_fence(__ATOMIC_ACQUIRE, "agent");
            xb_add(&bar[XB_XGEN(b.x)], 1u);
            asm volatile("s_waitcnt vmcnt(0)" ::: "memory");
        } else {
            XB_SPIN(xb_ld(&bar[XB_XGEN(b.x)]) == gen, bar);
            __builtin_amdgcn_fence(__ATOMIC_ACQUIRE, "agent");
            asm volatile("s_waitcnt vmcnt(0)" ::: "memory");
        }
    }
    __syncthreads();
}

__device__ __forceinline__ void p0_transpose_item(const float* W, int ldsrc, int col0, int nblk, bf16_t* WT, int ldk, int row_off, LAS float* scr, int item, int lane) {
    const int kb = item / nblk, nb = item % nblk, k0 = 64 * kb, n0 = 32 * nb;
#pragma unroll
    for (int i = 0; i < 32; ++i) { const int kk = 2 * i + (lane >> 5); scr[kk * 33 + (lane & 31)] = W[(size_t)(k0 + kk) * ldsrc + col0 + n0 + (lane & 31)]; }
    asm volatile("s_waitcnt lgkmcnt(0)" ::: "memory");
    const int c = lane & 7;
#pragma unroll
    for (int j = 0; j < 4; ++j) { const int n = (lane >> 3) + 8 * j; const LAS float* s = scr + (8 * c) * 33 + n;
        u32x4 o; o.x = pk2(s[0 * 33], s[1 * 33]); o.y = pk2(s[2 * 33], s[3 * 33]); o.z = pk2(s[4 * 33], s[5 * 33]); o.w = pk2(s[6 * 33], s[7 * 33]);
        *(u32x4*)(WT + (size_t)(row_off + n0 + n) * ldk + k0 + 8 * c) = o; }
    asm volatile("s_waitcnt lgkmcnt(0)" ::: "memory");
}

struct Args {
    const float* x; const float* c; const float* w_ada; const float* b_ada; const float* w_in; const float* b_gate; const float* norm_w; const float* w_out;
    const float* ln1_g; const float* ln1_b; const float* w_ff1; const float* b_ff1; const float* w_ff2; const float* b_ff2; const float* ln2_g; const float* ln2_b;
    float* out; unsigned char* ws; int ldw; int pad;
};

#define LDS_BARRIER() do { asm volatile("s_waitcnt lgkmcnt(0)" ::: "memory"); __builtin_amdgcn_s_barrier(); asm volatile("" ::: "memory"); } while (0)
#ifndef PROBE_PH
#define PROBE_PH -1
#endif
#ifndef PROBE_HI
#define PROBE_HI (PROBE_PH + 1)
#endif
#define PROBE_MULT 8
#define STAMP(i) do { if (PROBE_PH >= 0 && blockIdx.x == 0 && threadIdx.x == 0) TS[i] = __builtin_amdgcn_s_memrealtime(); } while (0)
__global__ void __launch_bounds__(512, 2) fwd_kernel(Args a) {
    extern __shared__ __attribute__((aligned(16))) unsigned char lds_raw[];
    LAS unsigned char* lds = (LAS unsigned char*)lds_raw;
    cg::grid_group grid = cg::this_grid();
    const int G = gridDim.x, blk = blockIdx.x, NGW = G * 8, NGT = G * 512;
#define PHASE_IDS() int tid_l = threadIdx.x; asm volatile("" : "+v"(tid_l)); const int tid = tid_l, lane = tid & 63, wave = __builtin_amdgcn_readfirstlane(tid >> 6); \
    const int gw = blk * 8 + wave, gt = blk * 512 + tid; (void)gw; (void)gt; (void)lane; (void)NGW; (void)NGT
#define mod ((float*)(a.ws + WS_MOD))
#define TW ((f32x2*)(a.ws + WS_TW))
#define ST1 ((f32x2*)(a.ws + WS_ST1))
#define MIN ((float*)(a.ws + WS_MIN))
#define SC ((f32x2*)(a.ws + WS_SC))
#define B1 ((bf16_t*)(a.ws + WS_B1))
#define B2 ((bf16_t*)(a.ws + WS_B2))
#define B1F ((bf16_t*)(a.ws + WS_B1F))
#define WTMP ((bf16_t*)(a.ws + WS_WTMP))
#define TS ((unsigned long long*)(a.ws + WS_TS))
#define SCALP ((float*)(a.ws + WS_SCAL))
#define WCAT ((bf16_t*)(a.ws + WS_WCAT))
#define WOUT ((bf16_t*)(a.ws + WS_WOUT))
#define W1 ((bf16_t*)(a.ws + WS_W1))
#define W2 ((bf16_t*)(a.ws + WS_W2))
#define Hb ((bf16_t*)(a.ws + WS_H))
#define QK ((bf16_t*)(a.ws + WS_QK))
#define Vb ((bf16_t*)(a.ws + WS_V))
#define Ob ((bf16_t*)(a.ws + WS_O))
#define GATES ((float*)(a.ws + WS_GATES))
#define FZ ((bf16_t*)(a.ws + WS_FZ))
#define F1O ((bf16_t*)(a.ws + WS_F1O))
#define AOUT ((bf16_t*)(a.ws + WS_AOUT))
#define KVL ((float*)(a.ws + WS_KVL))
#define CST ((bf16_t*)(a.ws + WS_CST))
#define HID ((bf16_t*)(a.ws + WS_HID))
#define U16 ((bf16_t*)(a.ws + WS_U16))
#define V16 ((bf16_t*)(a.ws + WS_H))
    const int ldw = a.ldw;

    STAMP(0);
    {
        PHASE_IDS();
        if (blk == 0) for (int i = tid; i < XCD_BAR_WORDS; i += 512) ((unsigned*)(a.ws + WS_BAR))[i] = 0u;
        if (tid < 4) ((LAS unsigned*)(lds + 143360))[tid] = 0u;
        if (blk < 192) {
            LAS float* sc = (LAS float*)lds;
            LAS float* red = (LAS float*)(lds + 8192);
            for (int i = tid; i < 2048; i += 512) { const float v = a.c[i]; sc[i] = v / (1.0f + expf(-v)); }
            __syncthreads();
            const int col = lane & 31, par = lane >> 5; float a0 = 0.f, a1 = 0.f;
            const float* wp = a.w_ada + (size_t)(wave * 128 + par) * 6144 + blk * 32 + col;
            float wv[64];
#pragma unroll
            for (int i = 0; i < 64; ++i) wv[i] = wp[(size_t)(2 * i) * 6144];
#pragma unroll
            for (int i = 0; i < 64; ++i) { const int k = wave * 128 + 2 * i + par; a0 += sc[k] * wv[i]; a1 += sc[1024 + k] * wv[i]; }
            a0 += __shfl_xor(a0, 32); a1 += __shfl_xor(a1, 32);
            if (par == 0) { red[(wave * 2 + 0) * 32 + col] = a0; red[(wave * 2 + 1) * 32 + col] = a1; }
            __syncthreads();
            if (tid < 64) { const int b = tid >> 5, l = tid & 31; float s = a.b_ada[blk * 32 + l];
#pragma unroll
                for (int w = 0; w < 8; ++w) s += red[(w * 2 + b) * 32 + l];
                mod[b * 6144 + blk * 32 + l] = s; }
        }
        __syncthreads();
        LAS float* scr = (LAS float*)(lds + wave * 16384);
        constexpr int I_A = 16 * 48, I_B = 16 * 16, I_C = 8 * 32, I_F = 8 * 32, I_D = 16 * 128, I_E = 64 * 32, NITEMS = I_A + I_B + I_C + I_F + I_D + I_E;
        for (int it = gw; it < NITEMS; it += NGW) {
            int r = it;
            if (r < I_A) { p0_transpose_item(a.w_in, ldw, 0, 48, WCAT, DM, 0, scr, r, lane); continue; } r -= I_A;
            if (r < I_B) { p0_transpose_item(a.w_in, ldw, 1536, 16, WCAT, DM, 1792, scr, r, lane); continue; } r -= I_B;
            if (r < I_C) { p0_transpose_item(a.w_out, DM, 0, 32, WOUT, KOUT, 0, scr, r, lane); continue; } r -= I_C;
            if (r < I_F) { p0_transpose_item(a.w_out + (size_t)512 * DM, DM, 0, 32, WTMP, 512, 0, scr, r, lane); continue; } r -= I_F;
            if (r < I_D) { p0_transpose_item(a.w_ff1, FF, 0, 128, W1, DM, 0, scr, r, lane); continue; } r -= I_D;
            p0_transpose_item(a.w_ff2, DM, 0, 32, W2, FF, 0, scr, r, lane);
        }
        for (int i = gt; i < 16 * 1024; i += NGT) { const int gcol = i >> 10, k = i & 1023; WCAT[(size_t)(1536 + gcol) * DM + k] = (bf16_t)f2bf(a.w_in[(size_t)k * ldw + 2048 + gcol]); }
        for (int i = gt; i < 240 * 128; i += NGT) *(u32x4*)(WCAT + (size_t)1552 * DM + (size_t)i * 8) = (u32x4){0u, 0u, 0u, 0u};
        const float isq = 0.08838834764831845f;
        for (int i = gt; i < 256 * 128; i += NGT) { const int n = i >> 7, s1 = i & 127, ri = n >> 7, k1 = n & 127; float s, c; sincospif((float)((k1 * s1) & 127) * (1.0f / 64.0f), &s, &c);
            B1[i] = (bf16_t)f2bf((ri ? -s : c) * isq); B1F[i] = (bf16_t)f2bf((ri ? s : c) * isq); }
        for (int i = gt; i < 256 * 256; i += NGT) { const int n = i >> 8, kk = i & 255, ro = n >> 7, k2 = n & 127, ri = kk >> 7, s2 = kk & 127; float s, c; sincospif((float)((k2 * s2) & 127) * (1.0f / 64.0f), &s, &c);
            const float v = (ro == 0) ? (ri == 0 ? c : s) : (ri == 0 ? -s : c); B2[i] = (bf16_t)f2bf(v * isq); }
        for (int i = gt; i < 16384; i += NGT) { float s, c; sincospif((float)i * (1.0f / 8192.0f), &s, &c); TW[i] = (f32x2){c, s}; }
    }
    grid.sync();
    const XcdBarrier xbar = xcd_barrier_post((unsigned*)(a.ws + WS_BAR), (volatile LAS unsigned*)(lds + 143360));
    STAMP(1);

    {
        pg8::Gemm g; g.A = WTMP; g.Bt = B1F; g.M = 4096; g.N = 256; g.K = 128; g.lda = 1024u; g.hstep = (size_t)128 * 1024; g.tdiv = 4; g.thi = 256; g.tlo = (size_t)256 * 1024;
        pg8::StaticOrder S; S.init(4096, 256, G, blk);
        pg8::EpiFold E{WOUT};
        pg8::gemm_phase<pg8::EpiFold, false>(lds, g, S, E);
    }
    { PHASE_IDS();
    for (int m0 = gw * 4; m0 < MT; m0 += NGW * 4) {
        f32x4 v[4][4]; LN_LOAD4(v, a.x, m0);
        const float* mb = mod + (size_t)(m0 >> 14) * 6144;
        f32x4 shv[4], scv[4];
#pragma unroll
        for (int j = 0; j < 4; ++j) { shv[j] = ((const f32x4*)mb)[lane + 64 * j]; scv[j] = ((const f32x4*)(mb + 1024))[lane + 64 * j] + 1.0f; }
        float sq[8]; LN_STATS4(v, sq);
#pragma unroll
        for (int r = 0; r < 4; ++r) { u32x2* o8 = (u32x2*)(Hb + (size_t)(m0 + r) * DM) + lane;
#pragma unroll
            for (int j = 0; j < 4; ++j) {
                const f32x4 y = (v[r][j] - sq[r]) * sq[4 + r] * scv[j] + shv[j]; u32x2 w; w.x = pk2(y[0], y[1]); w.y = pk2(y[2], y[3]); o8[64 * j] = w; } }
    }
    }
    xcd_barrier(xbar);
    STAMP(2);

    {
        pg8::Gemm g; g.A = Hb; g.Bt = WCAT + (size_t)1792 * DM; g.M = MT; g.N = 512; g.K = DM; g.lda = 128u * DM * 2u; g.hstep = (size_t)DM * 2; g.tdiv = 64; g.thi = (size_t)SEQ * DM * 2; g.tlo = (size_t)2 * DM * 2;
        pg8::StaticOrder S; S.init(MT, 512, G, blk);
        pg8::EpiF0 E{FZ};
        pg8::gemm_phase<pg8::EpiF0, true>(lds, g, S, E);
    }
    {
        pg8::Gemm g = pg8::std_gemm(Hb, WCAT, MT, 1792, DM);
        pg8::StaticOrder S; S.init(MT, 1792, G, blk);
        pg8::EpiMain E{QK, Vb, Ob, GATES, a.b_gate};
        pg8::gemm_phase<pg8::EpiMain, false>(lds, g, S, E);
    }
    xcd_barrier(xbar);
    STAMP(3);

    {
        pg8::Gemm g = pg8::std_gemm(FZ, B1, NB * 512 * 128, 256, 128);
        pg8::StaticOrder S; S.init(NB * 512 * 128, 256, G, blk);
        pg8::EpiF1 E{F1O, TW};
        pg8::gemm_phase<pg8::EpiF1, true>(lds, g, S, E);
    }
    {
        PHASE_IDS();
        LAS bf16_t* KsT = (LAS bf16_t*)lds;
        LAS bf16_t* VT = (LAS bf16_t*)(lds + 34816);
        LAS float* gl = (LAS float*)(lds + 69632);
        LAS float* gg = (LAS float*)(lds + 69632 + 2048);
        LAS float* wk = (LAS float*)(lds + 69632 + 3072);
        LAS float* aa = (LAS float*)(lds + 69632 + 4096);
        const int fr = lane & 15, fq = lane >> 4, fq8 = fq * 8, fq8x = (fq * 8) ^ 16;
        const int s_st = tid >> 2, q4 = tid & 3, s_sw = s_st ^ (16 * q4);
        float gpre[4]; bf16x8 kpre[2], vpre[4];
#define M1_PREFETCH(u_) do { const int chunk_ = (u_) & 127, h_ = ((u_) >> 7) & 3, b_ = (u_) >> 9; const size_t tok_ = (size_t)b_ * SEQ + chunk_ * 128; \
            if (tid < 128) { _Pragma("unroll") for (int ty = 0; ty < 4; ++ty) gpre[ty] = GATES[(tok_ + tid) * 16 + ty * 4 + h_]; } \
            const bf16_t* kp_ = QK + (tok_ + s_st) * 512 + 256 + h_ * 64 + q4 * 16; kpre[0] = *(const bf16x8*)kp_; kpre[1] = *(const bf16x8*)(kp_ + 8); \
            const bf16_t* vp_ = Vb + (tok_ + s_st) * 512 + h_ * 128 + q4 * 32; _Pragma("unroll") for (int c = 0; c < 4; ++c) vpre[c] = *(const bf16x8*)(vp_ + c * 8); } while (0)
        if (blk < NB * NH * NCHUNK) M1_PREFETCH(blk);
        for (int u = blk; u < NB * NH * NCHUNK; u += G) {
            const int chunk = u & 127, h = (u >> 7) & 3, b = u >> 9;
            const int chain_f = (b * NH + h) * 2;
            float* scal = SCALP + (size_t)u * 768;
            LDS_BARRIER();
            if (tid < 128) {
#pragma unroll
                for (int ty = 0; ty < 4; ++ty) gl[ty * 128 + tid] = gpre[ty];
            }
            LDS_BARRIER();
            if (tid < 128) {
                float bf_ = 0.f, totf = 0.f, br_ = 0.f, totb = 0.f;
#pragma unroll 8
                for (int r4 = 0; r4 < 32; ++r4) { const f32x4 f4 = *(const LAS f32x4*)(gl + 128 + 4 * r4), b4 = *(const LAS f32x4*)(gl + 384 + 4 * r4);
#pragma unroll
                    for (int q = 0; q < 4; ++q) { const int r = 4 * r4 + q; totf += f4[q]; totb += b4[q]; bf_ += (r <= tid) ? f4[q] : 0.f; br_ += (r >= tid) ? b4[q] : 0.f; } }
                const float li_f = gl[tid], li_b = gl[256 + tid];
                gg[tid] = totf - bf_ + li_f; gg[128 + tid] = totb - br_ + li_b;
                aa[tid] = li_f - bf_; aa[128 + tid] = li_b - br_;
                scal[tid] = li_f - bf_; scal[128 + tid] = li_b - br_; scal[512 + tid] = bf_; scal[640 + tid] = br_;
                if (tid == 0) { wk[0] = totf; wk[1] = totb; }
            }
            LDS_BARRIER();
            if (tid < 128) {
                float mlf = -3.0e38f, mlb = -3.0e38f, cmf = -3.0e38f, cmb = -3.0e38f;
#pragma unroll 8
                for (int r4 = 0; r4 < 32; ++r4) { const f32x4 g0 = *(const LAS f32x4*)(gg + 4 * r4), g1 = *(const LAS f32x4*)(gg + 128 + 4 * r4), x0 = *(const LAS f32x4*)(aa + 4 * r4), x1 = *(const LAS f32x4*)(aa + 128 + 4 * r4);
#pragma unroll
                    for (int q = 0; q < 4; ++q) { const int r = 4 * r4 + q; mlf = fmaxf(mlf, g0[q]); mlb = fmaxf(mlb, g1[q]);
                        cmf = (r <= tid) ? fmaxf(cmf, x0[q]) : cmf; cmb = (r >= tid) ? fmaxf(cmb, x1[q]) : cmb; } }
                scal[256 + tid] = cmf; scal[384 + tid] = cmb;
                const float tf = wk[0], tb = wk[1];
                if (tid == 0) { SC[(size_t)chain_f * 128 + chunk] = (f32x2){tf, mlf}; SC[(size_t)(chain_f + 1) * 128 + chunk] = (f32x2){tb, mlb}; }
                gl[tid] = __expf(gg[tid] - mlf); gl[128 + tid] = __expf(gg[128 + tid] - mlb);
            }
            LDS_BARRIER();
            {
                const float wf = gl[s_st], wb = gl[128 + s_st];
#pragma unroll
                for (int j = 0; j < 8; ++j) { const float a0 = bf2f((unsigned short)kpre[0][j]), a1 = bf2f((unsigned short)kpre[1][j]); const int d0 = q4 * 16 + j, d1 = d0 + 8;
                    KsT[d0 * 136 + s_sw] = (bf16_t)f2bf(a0 * wf); KsT[d1 * 136 + s_sw] = (bf16_t)f2bf(a1 * wf);
                    KsT[(64 + d0) * 136 + s_sw] = (bf16_t)f2bf(a0 * wb); KsT[(64 + d1) * 136 + s_sw] = (bf16_t)f2bf(a1 * wb); }
#pragma unroll
                for (int c = 0; c < 4; ++c)
#pragma unroll
                    for (int j = 0; j < 8; ++j) VT[(q4 * 32 + c * 8 + j) * 136 + s_sw] = (bf16_t)vpre[c][j];
            }
            if (u + G < NB * NH * NCHUNK) M1_PREFETCH(u + G);
            LDS_BARRIER();
            {
                f32x4 acc[8];
#pragma unroll
                for (int n = 0; n < 8; ++n) acc[n] = (f32x4){0.f, 0.f, 0.f, 0.f};
#pragma unroll
                for (int ks = 0; ks < 4; ++ks) { const bf16x8 af = *(const LAS bf16x8*)(KsT + (wave * 16 + fr) * 136 + ((ks * 32) ^ (32 * ((wave >> 1) & 1))) + ((wave & 1) ? fq8x : fq8));
#pragma unroll
                    for (int n = 0; n < 8; ++n) { const bf16x8 bfv = *(const LAS bf16x8*)(VT + (n * 16 + fr) * 136 + ((ks * 32) ^ (32 * ((n >> 2) & 1))) + (((n >> 1) & 1) ? fq8x : fq8));
                        acc[n] = __builtin_amdgcn_mfma_f32_16x16x32_bf16(af, bfv, acc[n], 0, 0, 0); } }
                const int dir = wave >> 2, d = (wave & 3) * 16 + 4 * fq;
                float* dst = KVL + ((size_t)(chain_f + dir) * 128 + chunk) * ST_ROW;
#pragma unroll
                for (int n = 0; n < 8; ++n) *(f32x4*)(dst + (n * 16 + fr) * 64 + d) = acc[n];
                if (tid < 128) { float s = 0.f;
#pragma unroll
                    for (int r8 = 0; r8 < 16; ++r8) { const bf16x8 kk = *(const LAS bf16x8*)(KsT + tid * 136 + 8 * r8);
#pragma unroll
                        for (int q = 0; q < 8; ++q) s += bf2f((unsigned short)kk[q]); }
                    KVL[((size_t)(chain_f + (tid >> 6)) * 128 + chunk) * ST_ROW + 128 * 64 + (tid & 63)] = s; }
            }
        }
        LDS_BARRIER();
#undef M1_PREFETCH
    }
    xcd_barrier(xbar);
    STAMP(4);

    { PHASE_IDS();
    if (gt < 16 * (ST_ROW / 2)) {
        const int chain = gt / (ST_ROW / 2), p = gt % (ST_ROW / 2), dir = chain & 1;
        const float* src = KVL + (size_t)chain * 128 * ST_ROW + 2 * p; bf16_t* dst = CST + (size_t)chain * 128 * ST_ROW + 2 * p;
        const f32x2* scp = SC + (size_t)chain * 128; float* mo = MIN + chain * 128;
        float c0 = 0.f, c1 = 0.f, m = 0.f;
        for (int i0 = 0; i0 < 128; i0 += 8) {
            f32x2 kv[8], sc[8];
#pragma unroll
            for (int q = 0; q < 8; ++q) { const int j = dir ? 127 - (i0 + q) : (i0 + q); kv[q] = *(const f32x2*)(src + (size_t)j * ST_ROW); sc[q] = scp[j]; }
#pragma unroll
            for (int q = 0; q < 8; ++q) { const int j = dir ? 127 - (i0 + q) : (i0 + q);
                *(unsigned*)(dst + (size_t)j * ST_ROW) = pk2(c0, c1); if (p == 0) mo[j] = m;
                const float mn = fmaxf(sc[q].x + m, sc[q].y), dec = expf(sc[q].x + m - mn), wl = expf(sc[q].y - mn);
                c0 = dec * c0 + wl * kv[q].x; c1 = dec * c1 + wl * kv[q].y; m = mn; }
        }
    }
    }
    {
        pg8::Gemm g = pg8::std_gemm(F1O, B2, NB * 128 * 512, 256, 256);
        pg8::StaticOrder S; S.init(NB * 128 * 512, 256, G, blk);
        pg8::EpiF2 E{AOUT};
        pg8::gemm_phase<pg8::EpiF2, true>(lds, g, S, E);
    }
    xcd_barrier(xbar);
    STAMP(5);

    {
        PHASE_IDS();
        LAS bf16_t* Kx = (LAS bf16_t*)lds;
        LAS bf16_t* VT = (LAS bf16_t*)(lds + 20736);
        LAS bf16_t* CfT = (LAS bf16_t*)(lds + 55552);
        LAS bf16_t* CbT = (LAS bf16_t*)(lds + 73984);
        LAS float* sc6 = (LAS float*)(lds + 92416);
        const int fr = lane & 15, fq = lane >> 4;
        const int s_st = tid >> 2, q4 = tid & 3;
        if (tid >= 64 && tid < 64 + 14 * 9) { const int c = tid - 64; *(LAS u32x4*)(Kx + 130 * 72 + c * 8) = (u32x4){0u, 0u, 0u, 0u}; }
        u32x4 kpre[2], cfpre[2], cbpre[2], npre, scpre; bf16x8 vpre[4];
#define M3_PREFETCH(u_) do { const int h_ = (u_) & 3, chunk_ = ((u_) >> 2) & 127, b_ = (u_) >> 9; const size_t tok_ = (size_t)b_ * SEQ + chunk_ * 128; const int cf_ = (b_ * NH + h_) * 2; \
            const bf16_t* cfp_ = CST + ((size_t)cf_ * 128 + chunk_) * ST_ROW; const bf16_t* cbp_ = CST + ((size_t)(cf_ + 1) * 128 + chunk_) * ST_ROW; \
            _Pragma("unroll") for (int i = 0; i < 2; ++i) { const int c = tid + i * 512, s = c >> 3, part = c & 7; \
                kpre[i] = *(const u32x4*)(QK + (tok_ + s) * 512 + 256 + h_ * 64 + part * 8); cfpre[i] = *(const u32x4*)(cfp_ + s * 64 + part * 8); cbpre[i] = *(const u32x4*)(cbp_ + s * 64 + part * 8); } \
            if (tid < 16) npre = *(const u32x4*)(((tid >> 3) ? cbp_ : cfp_) + 128 * 64 + (tid & 7) * 8); \
            if (tid < 192) scpre = *(const u32x4*)(SCALP + (size_t)((b_ * NH + h_) * 128 + chunk_) * 768 + tid * 4); \
            const bf16_t* vp_ = Vb + (tok_ + s_st) * 512 + h_ * 128 + q4 * 32; _Pragma("unroll") for (int c = 0; c < 4; ++c) vpre[c] = *(const bf16x8*)(vp_ + c * 8); } while (0)
        if (blk < NB * NH * NCHUNK) M3_PREFETCH(blk);
        for (int u = blk; u < NB * NH * NCHUNK; u += G) {
            const int h = u & 3, chunk = (u >> 2) & 127, b = u >> 9; const size_t tok0 = (size_t)b * SEQ + chunk * 128;
            const int chain_f = (b * NH + h) * 2;
            LDS_BARRIER();
            const int t = wave * 16 + fr;
            const bf16_t* qp = QK + (tok0 + t) * 512 + h * 64 + fq * 8;
            const bf16x8 q0 = *(const bf16x8*)qp, q1 = *(const bf16x8*)(qp + 32);
            const float m_f = MIN[chain_f * 128 + chunk], m_b = MIN[(chain_f + 1) * 128 + chunk];
            {
#pragma unroll
                for (int i = 0; i < 2; ++i) { const int c = tid + i * 512, s = c >> 3, part = c & 7;
                    *(LAS u32x4*)(Kx + s * 72 + part * 8) = kpre[i]; *(LAS u32x4*)(CfT + s * 72 + part * 8) = cfpre[i]; *(LAS u32x4*)(CbT + s * 72 + part * 8) = cbpre[i]; }
                if (tid < 16) *(LAS u32x4*)(Kx + (128 + (tid >> 3)) * 72 + (tid & 7) * 8) = npre;
                if (tid < 192) *(LAS u32x4*)(sc6 + tid * 4) = scpre;
#pragma unroll
                for (int c = 0; c < 4; ++c)
#pragma unroll
                    for (int j = 0; j < 8; ++j) VT[(q4 * 32 + c * 8 + j) * 136 + (s_st ^ (16 * q4))] = (bf16_t)vpre[c][j];
            }
            LDS_BARRIER();
            if (u + G < NB * NH * NCHUNK) M3_PREFETCH(u + G);
            {
                f32x4 sacc[9];
#pragma unroll
                for (int n = 0; n < 9; ++n) { sacc[n] = (f32x4){0.f, 0.f, 0.f, 0.f};
                    const bf16x8 kf0 = *(const LAS bf16x8*)(Kx + (n * 16 + fr) * 72 + fq * 8), kf1 = *(const LAS bf16x8*)(Kx + (n * 16 + fr) * 72 + 32 + fq * 8);
                    sacc[n] = __builtin_amdgcn_mfma_f32_16x16x32_bf16(kf0, q0, sacc[n], 0, 0, 0);
                    sacc[n] = __builtin_amdgcn_mfma_f32_16x16x32_bf16(kf1, q1, sacc[n], 0, 0, 0); }
                const float qnf = __shfl(sacc[8][0], fr), qnb = __shfl(sacc[8][1], fr);
                const float Mf = fmaxf(m_f, sc6[256 + t]), Mb = fmaxf(m_b, sc6[384 + t]);
                const float wif = __expf(m_f - Mf), wib = __expf(m_b - Mb), flf = __expf(-sc6[512 + t] - Mf), flb = __expf(-sc6[640 + t] - Mb);
                float sumf = 0.f, sumb = 0.f;
#pragma unroll
                for (int n = 0; n < 8; ++n) { const f32x4 af4 = *(const LAS f32x4*)(sc6 + n * 16 + 4 * fq), ab4 = *(const LAS f32x4*)(sc6 + 128 + n * 16 + 4 * fq);
#pragma unroll
                    for (int j = 0; j < 4; ++j) { const int s = n * 16 + 4 * fq + j; const float sv = sacc[n][j];
                        const float wf = (s <= t) ? __expf(af4[j] - Mf) : 0.f, wb = (s >= t) ? __expf(ab4[j] - Mb) : 0.f;
                        sumf += sv * wf; sumb += sv * wb; } }
                sumf += __shfl_xor(sumf, 16); sumf += __shfl_xor(sumf, 32); sumb += __shfl_xor(sumb, 16); sumb += __shfl_xor(sumb, 32);
                const float denf = 0.125f * (sumf + wif * qnf), denb = 0.125f * (sumb + wib * qnb);
                const float rf = 0.125f / fmaxf(fabsf(denf), flf), rb = 0.125f / fmaxf(fabsf(denb), flb);
                bf16x8 pfr[4], qaf[2], qab[2];
#pragma unroll
                for (int ks = 0; ks < 4; ++ks) { float pv[8];
#pragma unroll
                    for (int hh = 0; hh < 2; ++hh) { const int n = 2 * ks + hh; const f32x4 af4 = *(const LAS f32x4*)(sc6 + n * 16 + 4 * fq), ab4 = *(const LAS f32x4*)(sc6 + 128 + n * 16 + 4 * fq);
#pragma unroll
                        for (int j = 0; j < 4; ++j) { const int s = n * 16 + 4 * fq + j;
                            const float wf = (s <= t) ? __expf(af4[j] - Mf) * rf : 0.f, wb = (s >= t) ? __expf(ab4[j] - Mb) * rb : 0.f;
                            pv[hh * 4 + j] = sacc[n][j] * (wf + wb); } }
                    u32x4 w; w.x = pk2(pv[0], pv[1]); w.y = pk2(pv[2], pv[3]); w.z = pk2(pv[4], pv[5]); w.w = pk2(pv[6], pv[7]);
                    pfr[ks] = __builtin_bit_cast(bf16x8, w); }
                const float cfw = rf * wif, cbw = rb * wib;
#pragma unroll
                for (int ks = 0; ks < 2; ++ks) { const bf16x8 qv = ks ? q1 : q0; unsigned tf[4], tb[4];
#pragma unroll
                    for (int j = 0; j < 4; ++j) { const float e0 = bf2f((unsigned short)qv[2 * j]), e1 = bf2f((unsigned short)qv[2 * j + 1]); tf[j] = pk2(e0 * cfw, e1 * cfw); tb[j] = pk2(e0 * cbw, e1 * cbw); }
                    const u32x4 wfv = (u32x4){tf[0], tf[1], tf[2], tf[3]}, wbv = (u32x4){tb[0], tb[1], tb[2], tb[3]};
                    qaf[ks] = __builtin_bit_cast(bf16x8, wfv); qab[ks] = __builtin_bit_cast(bf16x8, wbv); }
                const bf16_t* op = Ob + (tok0 + t) * 512 + h * 128 + 4 * fq;
                bf16x4 ogv[8];
#pragma unroll
                for (int ne = 0; ne < 8; ++ne) ogv[ne] = *(const bf16x4*)(op + ne * 16);
                f32x4 oacc[8];
#pragma unroll
                for (int ne = 0; ne < 8; ++ne) { oacc[ne] = (f32x4){0.f, 0.f, 0.f, 0.f}; const int e = ne * 16 + fr;
#pragma unroll
                    for (int ks = 0; ks < 4; ++ks) { const int sw = 16 * ((ne >> 1) & 3); const bf16x4 lo = *(const LAS bf16x4*)(VT + e * 136 + ((ks * 32) ^ sw) + 4 * fq), hi = *(const LAS bf16x4*)(VT + e * 136 + ((ks * 32 + 16) ^ sw) + 4 * fq);
                        const bf16x8 vf = (bf16x8){lo[0], lo[1], lo[2], lo[3], hi[0], hi[1], hi[2], hi[3]};
                        oacc[ne] = __builtin_amdgcn_mfma_f32_16x16x32_bf16(vf, pfr[ks], oacc[ne], 0, 0, 0); }
#pragma unroll
                    for (int ks = 0; ks < 2; ++ks) { const bf16x8 c1 = *(const LAS bf16x8*)(CfT + e * 72 + ks * 32 + fq * 8), c2 = *(const LAS bf16x8*)(CbT + e * 72 + ks * 32 + fq * 8);
                        oacc[ne] = __builtin_amdgcn_mfma_f32_16x16x32_bf16(c1, qaf[ks], oacc[ne], 0, 0, 0);
                        oacc[ne] = __builtin_amdgcn_mfma_f32_16x16x32_bf16(c2, qab[ks], oacc[ne], 0, 0, 0); } }
                float s1 = 0.f;
#pragma unroll
                for (int ne = 0; ne < 8; ++ne) s1 += (oacc[ne][0] + oacc[ne][1]) + (oacc[ne][2] + oacc[ne][3]);
                s1 += __shfl_xor(s1, 16); s1 += __shfl_xor(s1, 32);
                const float mu = s1 * (1.0f / 128.0f); float s2 = 0.f;
#pragma unroll
                for (int ne = 0; ne < 8; ++ne) { oacc[ne] = oacc[ne] - mu; s2 += (oacc[ne][0] * oacc[ne][0] + oacc[ne][1] * oacc[ne][1]) + (oacc[ne][2] * oacc[ne][2] + oacc[ne][3] * oacc[ne][3]); }
                s2 += __shfl_xor(s2, 16); s2 += __shfl_xor(s2, 32);
                const float rstd = 1.0f / sqrtf(s2 * (1.0f / 128.0f) + LN_EPS);
                bf16_t* yp = AOUT + (tok0 + t) * KOUT + h * 128 + 4 * fq; const float* nw = a.norm_w + h * 128 + 4 * fq;
#pragma unroll
                for (int ne = 0; ne < 8; ++ne) { const f32x4 wv = *(const f32x4*)(nw + ne * 16); float y[4];
#pragma unroll
                    for (int j = 0; j < 4; ++j) { const float og = bf2f((unsigned short)ogv[ne][j]); y[j] = oacc[ne][j] * rstd * wv[j] / (1.0f + __expf(-og)); }
                    u32x2 w; w.x = pk2(y[0], y[1]); w.y = pk2(y[2], y[3]); *(u32x2*)(yp + ne * 16) = w; }
            }
        }
        LDS_BARRIER();
#undef M3_PREFETCH
    }
    xcd_barrier(xbar);
    STAMP(6);

    {
        pg8::Gemm g = pg8::std_gemm(AOUT, WOUT, MT, DM, KOUT);
        pg8::StaticOrder S; S.init(MT, DM, G, blk);
        pg8::EpiOut E{a.x, U16, mod};
        pg8::gemm_phase<pg8::EpiOut, false>(lds, g, S, E);
    }
    xcd_barrier(xbar);
    STAMP(7);

    { PHASE_IDS();
    for (int m0 = gw * 4; m0 < MT; m0 += NGW * 4) {
        f32x4 v[4][4]; LN_LOAD4_BF16(v, U16, m0);
        const float* mb = mod + (size_t)(m0 >> 14) * 6144;
        f32x4 shv[4], scv[4], lgv[4], lbv[4];
#pragma unroll
        for (int j = 0; j < 4; ++j) { shv[j] = LN_PARAM(mb + 3072, j); scv[j] = LN_PARAM(mb + 4096, j) + 1.0f; lgv[j] = LN_PARAM(a.ln1_g, j); lbv[j] = LN_PARAM(a.ln1_b, j); }
        float sq[8]; LN_STATS4(v, sq);
        if (lane < 4) { const float mu_ = lane == 0 ? sq[0] : (lane == 1 ? sq[1] : (lane == 2 ? sq[2] : sq[3])), rs_ = lane == 0 ? sq[4] : (lane == 1 ? sq[5] : (lane == 2 ? sq[6] : sq[7]));
            ST1[m0 + lane] = (f32x2){mu_, rs_}; }
#pragma unroll
        for (int r = 0; r < 4; ++r)
#pragma unroll
            for (int j = 0; j < 4; ++j) v[r][j] = (v[r][j] - sq[r]) * sq[4 + r] * lgv[j] + lbv[j];
        LN_STATS4(v, sq);
#pragma unroll
        for (int r = 0; r < 4; ++r) { bf16_t* orow = Hb + (size_t)(m0 + r) * DM + 8 * lane;
#pragma unroll
            for (int hf = 0; hf < 2; ++hf) { const f32x4 y0 = (v[r][2 * hf] - sq[r]) * sq[4 + r] * scv[2 * hf] + shv[2 * hf], y1 = (v[r][2 * hf + 1] - sq[r]) * sq[4 + r] * scv[2 * hf + 1] + shv[2 * hf + 1];
                u32x4 w; w.x = pk2(y0[0], y0[1]); w.y = pk2(y0[2], y0[3]); w.z = pk2(y1[0], y1[1]); w.w = pk2(y1[2], y1[3]); *(u32x4*)(orow + hf * 512) = w; } }
    }
    }
    xcd_barrier(xbar);
    STAMP(8);

    {
        pg8::Gemm g = pg8::std_gemm(Hb, W1, MT, FF, DM);
        pg8::StaticOrder S; S.init(MT, FF, G, blk);
        pg8::EpiFF1 E{HID, a.b_ff1};
        pg8::gemm_phase<pg8::EpiFF1, false>(lds, g, S, E);
    }
    xcd_barrier(xbar);
    STAMP(9);

    {
        pg8::Gemm g = pg8::std_gemm(HID, W2, MT, DM, FF);
        pg8::StaticOrder S; S.init(MT, DM, G, blk);
        pg8::EpiFF2 E{U16, V16, mod, ST1, a.ln1_g, a.ln1_b, a.b_ff2};
        pg8::gemm_phase<pg8::EpiFF2, false>(lds, g, S, E);
    }
    xcd_barrier(xbar);
    STAMP(10);

    { PHASE_IDS();
    for (int m0 = gw * 4; m0 < MT; m0 += NGW * 4) {
        f32x4 v[4][4]; LN_LOAD4_BF16(v, V16, m0);
        f32x4 lgv[4], lbv[4];
#pragma unroll
        for (int j = 0; j < 4; ++j) { lgv[j] = LN_PARAM(a.ln2_g, j); lbv[j] = LN_PARAM(a.ln2_b, j); }
        float sq[8]; LN_STATS4(v, sq);
#pragma unroll
        for (int r = 0; r < 4; ++r) { float* orow = a.out + (size_t)(m0 + r) * DM + 8 * lane;
#pragma unroll
            for (int j = 0; j < 4; ++j) *(f32x4*)(orow + (j >> 1) * 512 + 4 * (j & 1)) = (v[r][j] - sq[r]) * sq[4 + r] * lgv[j] + lbv[j]; }
    }
    }
    if (PROBE_PH >= 0 && blockIdx.x == 0 && threadIdx.x == 0) {
        const unsigned long long t1 = __builtin_amdgcn_s_memrealtime(); TS[11] = t1;
        const unsigned long long span = (TS[PROBE_HI] - TS[PROBE_PH]) * PROBE_MULT;
        while (__builtin_amdgcn_s_memrealtime() - t1 < span) __builtin_amdgcn_s_sleep(8);
    }
}

extern "C" void kernel_launch(void* const* d_in, const int* in_sizes, int n_in, void* d_out, int out_size, void* d_ws, size_t ws_size, hipStream_t stream) {
    static int grid = 0;
    if (grid == 0) {
        if (n_in != 16 || out_size != MT * DM || ws_size < WS_END) { fprintf(stderr, "kernel_launch: unexpected shapes (n_in %d, out %d, ws %zu)\n", n_in, out_size, ws_size); grid = -1; return; }
        int dev = 0, cus = 0, per_cu = 0;
        hipGetDevice(&dev);
        hipDeviceGetAttribute(&cus, hipDeviceAttributeMultiprocessorCount, dev);
        hipFuncSetAttribute((const void*)fwd_kernel, hipFuncAttributeMaxDynamicSharedMemorySize, LDS_BYTES);
        hipOccupancyMaxActiveBlocksPerMultiprocessor(&per_cu, (const void*)fwd_kernel, 512, LDS_BYTES);
        if (per_cu < 1) per_cu = 1;
        grid = cus * per_cu;
        if (grid > 256) grid = 256;
        (void)hipGetLastError();
    }
    if (grid < 0) return;
    Args a{};
    a.x = (const float*)d_in[0]; a.c = (const float*)d_in[1]; a.w_ada = (const float*)d_in[2]; a.b_ada = (const float*)d_in[3]; a.w_in = (const float*)d_in[4];
    a.b_gate = (const float*)d_in[5]; a.norm_w = (const float*)d_in[6]; a.w_out = (const float*)d_in[7]; a.ln1_g = (const float*)d_in[8]; a.ln1_b = (const float*)d_in[9];
    a.w_ff1 = (const float*)d_in[10]; a.b_ff1 = (const float*)d_in[11]; a.w_ff2 = (const float*)d_in[12]; a.b_ff2 = (const float*)d_in[13]; a.ln2_g = (const float*)d_in[14]; a.ln2_b = (const float*)d_in[15];
    a.out = (float*)d_out; a.ws = (unsigned char*)d_ws; a.ldw = in_sizes[4] / DM; a.pad = 0;
    void* args[] = {&a};
    hipError_t e = hipLaunchCooperativeKernel((const void*)fwd_kernel, dim3(grid), dim3(512), args, LDS_BYTES, stream);
    if (e != hipSuccess) fprintf(stderr, "cooperative launch failed: %s (grid %d)\n", hipGetErrorString(e), grid);
}
```

```cpp
#include <hip/hip_runtime.h>
#include <hip/hip_cooperative_groups.h>
#include <cstdio>
#include <cstdint>
namespace cg = cooperative_groups;

#define LAS __attribute__((address_space(3)))
typedef unsigned short bf16_t;
typedef short bf16x8 __attribute__((ext_vector_type(8)));
typedef short bf16x4 __attribute__((ext_vector_type(4)));
typedef float f32x4 __attribute__((ext_vector_type(4)));
typedef float f32x2 __attribute__((ext_vector_type(2)));
typedef unsigned u32x4 __attribute__((ext_vector_type(4)));
typedef unsigned u32x2 __attribute__((ext_vector_type(2)));

constexpr int NB = 2, SEQ = 16384, DM = 1024, MT = NB * SEQ, FF = 4096, NH = 4;
constexpr int NCHUNK = 128;
constexpr int NCAT = 2304;
constexpr int KOUT = 1536;
constexpr float LN_EPS = 1e-5f;
constexpr float ALPHA = 1.189207115002721f;
constexpr int ST_ROW = 129 * 64;

constexpr size_t KiB = 1024, MiB = 1u << 20;
constexpr size_t WS_MOD = 0, WS_TW = 64 * KiB, WS_ST1 = 192 * KiB, WS_MIN = 448 * KiB, WS_SC = 456 * KiB, WS_B1 = 512 * KiB, WS_B2 = 576 * KiB;
constexpr size_t WS_SCAL = 26 * MiB;
constexpr size_t WS_B1F = 704 * KiB, WS_TS = 768 * KiB, WS_BAR = 832 * KiB, WS_WTMP = 25 * MiB;
constexpr size_t WS_WCAT = 1 * MiB, WS_WOUT = 6 * MiB, WS_W1 = 9 * MiB, WS_W2 = 17 * MiB;
constexpr size_t WS_H = 32 * MiB;
constexpr size_t WS_QK = 96 * MiB, WS_V = 128 * MiB, WS_O = 160 * MiB, WS_GATES = 192 * MiB, WS_FZ = 194 * MiB, WS_F1O = 226 * MiB, WS_AOUT = 290 * MiB,
                 WS_KVL = 386 * MiB, WS_CST = 452 * MiB, WS_END = 486 * MiB;
constexpr size_t WS_U16 = 386 * MiB;
constexpr size_t WS_HID = 96 * MiB;
constexpr int LDS_BYTES = 147456;

__device__ __forceinline__ unsigned f2bf(float f) { unsigned u = __builtin_bit_cast(unsigned, f); return (u + 0x7fffu + ((u >> 16) & 1u)) >> 16; }
__device__ __forceinline__ unsigned pk2(float lo, float hi) { return f2bf(lo) | (f2bf(hi) << 16); }
__device__ __forceinline__ float bf2f(unsigned short h) { return __builtin_bit_cast(float, (unsigned)h << 16); }
__device__ __forceinline__ float wave_sum(float v) {
#pragma unroll
    for (int o = 1; o < 64; o <<= 1) v += __shfl_xor(v, o);
    return v;
}
__device__ __forceinline__ void wave_sum8(float (&s)[8]) {
#pragma unroll
    for (int o = 1; o < 64; o <<= 1) {
        float t[8];
#pragma unroll
        for (int i = 0; i < 8; ++i) t[i] = __shfl_xor(s[i], o);
#pragma unroll
        for (int i = 0; i < 8; ++i) s[i] += t[i];
    }
}
#define LN_LOAD4(dst, base, m0_) do { _Pragma("unroll") for (int r = 0; r < 4; ++r) { const f32x4* p_ = (const f32x4*)((base) + (size_t)((m0_) + r) * DM) + lane; \
        _Pragma("unroll") for (int j = 0; j < 4; ++j) dst[r][j] = p_[64 * j]; } } while (0)
#define LN_LOAD4_BF16(dst, base, m0_) do { _Pragma("unroll") for (int r = 0; r < 4; ++r) { const bf16_t* p_ = (base) + (size_t)((m0_) + r) * DM + 8 * lane; \
        _Pragma("unroll") for (int hf = 0; hf < 2; ++hf) { const u32x4 w_ = *(const u32x4*)(p_ + hf * 512); \
            dst[r][2 * hf][0] = __builtin_bit_cast(float, w_.x << 16); dst[r][2 * hf][1] = __builtin_bit_cast(float, w_.x & 0xffff0000u); dst[r][2 * hf][2] = __builtin_bit_cast(float, w_.y << 16); dst[r][2 * hf][3] = __builtin_bit_cast(float, w_.y & 0xffff0000u); \
            dst[r][2 * hf + 1][0] = __builtin_bit_cast(float, w_.z << 16); dst[r][2 * hf + 1][1] = __builtin_bit_cast(float, w_.z & 0xffff0000u); dst[r][2 * hf + 1][2] = __builtin_bit_cast(float, w_.w << 16); dst[r][2 * hf + 1][3] = __builtin_bit_cast(float, w_.w & 0xffff0000u); } } } while (0)
#define LN_PARAM(p, j) (*(const f32x4*)((p) + ((j) >> 1) * 512 + 8 * lane + 4 * ((j) & 1)))
#define LN_STATS4(v, sq) do { _Pragma("unroll") for (int r = 0; r < 4; ++r) { float s_ = 0.f, q_ = 0.f; \
        _Pragma("unroll") for (int j = 0; j < 4; ++j) { s_ += (v[r][j][0] + v[r][j][1]) + (v[r][j][2] + v[r][j][3]); \
            q_ += (v[r][j][0] * v[r][j][0] + v[r][j][1] * v[r][j][1]) + (v[r][j][2] * v[r][j][2] + v[r][j][3] * v[r][j][3]); } \
        sq[r] = s_; sq[4 + r] = q_; } wave_sum8(sq); \
        _Pragma("unroll") for (int r = 0; r < 4; ++r) { const float mean_ = sq[r] * (1.f / DM); const float var_ = fmaxf(sq[4 + r] * (1.f / DM) - mean_ * mean_, 0.f); sq[r] = mean_; sq[4 + r] = 1.f / sqrtf(var_ + LN_EPS); } } while (0)
__device__ __forceinline__ float log_sigmoid(float x) { return fminf(x, 0.f) - __logf(1.0f + __expf(-fabsf(x))); }

namespace pg8 {
constexpr int BM = 256, BK = 64, HALF = 128, HTB = HALF * BK * 2, STAGE_BYTES = 8 * HTB, NXCD = 8, WGM = 8;
__host__ __device__ __forceinline__ int lds_byte(int r, int c) { const int st = (r >> 4) * 2 + (c >> 5), rr = r & 15, cc = c & 31, ob = rr * 64 + cc * 2; return st * 1024 + (ob ^ (((ob >> 9) & 1) << 5)); }
__host__ __device__ __forceinline__ void stage_rc(int b, int& R, int& C) { const int st = b / 1024, sb = b % 1024, swz = sb ^ (((sb >> 9) & 1) << 5); R = (st >> 1) * 16 + swz / 64; C = (st & 1) * 32 + (swz % 64) / 2; }
__host__ __device__ __forceinline__ int perm32(int rho) { const int n = rho >> 4, i = rho & 15; return 8 * (i >> 2) + 4 * n + (i & 3); }

struct Unit { int pm, pn; };
struct Gemm { const bf16_t* A; const bf16_t* Bt; int M, N, K; unsigned lda; size_t hstep; int tdiv; size_t thi, tlo; };
__device__ __forceinline__ Gemm std_gemm(const bf16_t* A, const bf16_t* Bt, int M, int N, int K) {
    Gemm g; g.A = A; g.Bt = Bt; g.M = M; g.N = N; g.K = K; g.lda = (unsigned)K * 2u; g.hstep = (size_t)HALF * K * 2; g.tdiv = 1 << 30; g.thi = 0; g.tlo = (size_t)BM * K * 2; return g;
}

struct StaticOrder {
    int nM, nN, nwg, G, c;
    __device__ void init(int M, int N, int G_, int c_) { nM = M / BM; nN = N / BM; nwg = nM * nN; G = G_; c = c_; }
    __device__ bool next(int i, Unit& u) const {
        const long L = (long)i * G + c; if (L >= nwg) return false;
        int wgid = (int)L; { const int q = nwg / NXCD, r = nwg % NXCD, xcd = wgid % NXCD, off = wgid / NXCD; wgid = (xcd < r ? xcd * (q + 1) : r * (q + 1) + (xcd - r) * q) + off; }
        const int nig = WGM * nN, gid = wgid / nig, fm = gid * WGM, gsz = (nM - fm) < WGM ? (nM - fm) : WGM;
        u.pm = fm + ((wgid % nig) % gsz); u.pn = (wgid % nig) / gsz; return true;
    }
};

struct SplitOrder {
    int c, G, nscan, nunits;
    __device__ bool next(int i, Unit& u) const {
        int idx;
        if (c < nscan) { if (i > 0) return false; idx = c; } else { idx = nscan + (c - nscan) + i * (G - nscan); }
        if (idx >= nunits) return false;
        u.pm = idx; u.pn = 0; return true;
    }
};
struct SliceOrder {
    int c, c0, n;
    __device__ bool next(int i, Unit& u) const { if (i > 0 || c < c0 || c >= c0 + n) return false; u.pm = c - c0; u.pn = 0; return true; }
};

__device__ __forceinline__ unsigned cvt_pk_bf16(float lo, float hi) { unsigned r; asm volatile("v_cvt_pk_bf16_f32 %0, %1, %2" : "=v"(r) : "v"(lo), "v"(hi)); return r; }

template <class Epi, bool SWAP, class Sched = StaticOrder>
__device__ __forceinline__ void gemm_phase(LAS unsigned char* lds, const Gemm g, const Sched& S, const Epi& E) {
    int tid_ = threadIdx.x; asm volatile("" : "+v"(tid_));
    const int tid = tid_, wid = __builtin_amdgcn_readfirstlane(tid >> 6), lane = tid & 63, wr = wid >> 2, wc = wid & 3, fr = lane & 15, fq = lane >> 4;
    const int K = g.K, nt = K / BK;
    unsigned voffA[2], voffB[2];
#pragma unroll
    for (int i = 0; i < 2; ++i) { int R, C; stage_rc(tid * 16 + i * 8192, R, C); const int Rb = (Epi::PERM && !SWAP) ? ((R & ~31) + perm32(R & 31)) : R;
        voffA[i] = (unsigned)R * g.lda + (unsigned)C * 2u; voffB[i] = (unsigned)(Rb * K + C) * 2u; }
    const size_t kstep = (size_t)(BK * 2);
    const size_t hstepA = g.hstep;
    const size_t hstepB = (size_t)HALF * K * 2, tstepB = 2 * hstepB;
    const unsigned ldsw = (unsigned)wid * 1024u;
    const int aoff = lds_byte(wr * 64 + fr, fq * 8), boff = lds_byte(wc * 32 + fr, fq * 8);
#define PG8_SA(b, h) (((b) * 2 + (h)) * HTB)
#define PG8_SB(b, h) ((4 + (b) * 2 + (h)) * HTB)
#define PG8_ABASE(pm) ((const char*)g.A + (size_t)((pm) / g.tdiv) * g.thi + (size_t)((pm) % g.tdiv) * g.tlo)
#define PG8_STAGE(bufoff, gbase, voff) do { _Pragma("unroll") for (int _i = 0; _i < 2; ++_i) \
        __builtin_amdgcn_global_load_lds((const unsigned*)((const char*)(gbase) + (voff)[_i]), (LAS unsigned*)(lds + (bufoff) + ldsw + _i * 8192), 16, 0, 0); } while (0)
#define PG8_LDA(dst, b, h) do { _Pragma("unroll") for (int m = 0; m < 4; ++m) _Pragma("unroll") for (int k = 0; k < 2; ++k) dst[m][k] = *(const LAS bf16x8*)(lds + PG8_SA(b, h) + aoff + m * 2048 + k * 1024); } while (0)
#define PG8_LDB(dst, b, h) do { _Pragma("unroll") for (int n = 0; n < 2; ++n) _Pragma("unroll") for (int k = 0; k < 2; ++k) dst[n][k] = *(const LAS bf16x8*)(lds + PG8_SB(b, h) + boff + n * 2048 + k * 1024); } while (0)
#define PG8_MMA(ai, bj, At, Bt) do { __builtin_amdgcn_s_setprio(1); _Pragma("unroll") for (int m = 0; m < 4; ++m) _Pragma("unroll") for (int n = 0; n < 2; ++n) _Pragma("unroll") for (int k = 0; k < 2; ++k) \
        acc[ai][bj][m][n] = SWAP ? __builtin_amdgcn_mfma_f32_16x16x32_bf16(At[m][k], Bt[n][k], acc[ai][bj][m][n], 0, 0, 0) \
                                 : __builtin_amdgcn_mfma_f32_16x16x32_bf16(Bt[n][k], At[m][k], acc[ai][bj][m][n], 0, 0, 0); __builtin_amdgcn_s_setprio(0); } while (0)
#define PG8_WAIT_V(n) asm volatile("s_waitcnt vmcnt(" #n ")" ::: "memory")
#define PG8_WAIT_L(n) asm volatile("s_waitcnt lgkmcnt(" #n ")" ::: "memory")
#define PG8_BAR __builtin_amdgcn_s_barrier()
#define PG8_SCHED __builtin_amdgcn_sched_barrier(0)
    Unit cur, nxt; int ui = 0;
    if (!S.next(0, cur)) return;
    f32x4 acc[2][2][4][2];
#pragma unroll
    for (int a = 0; a < 2; ++a)
#pragma unroll
        for (int b = 0; b < 2; ++b)
#pragma unroll
            for (int m = 0; m < 4; ++m)
#pragma unroll
                for (int n = 0; n < 2; ++n) acc[a][b][m][n] = (f32x4){0.f, 0.f, 0.f, 0.f};
    bf16x8 At[4][2], B0[2][2], B1[2][2];
    const char* cA = PG8_ABASE(cur.pm); const char* cB = (const char*)g.Bt + (size_t)cur.pn * tstepB;
    PG8_STAGE(PG8_SB(0, 0), cB, voffB); PG8_STAGE(PG8_SB(0, 1), cB + hstepB, voffB); PG8_STAGE(PG8_SA(0, 0), cA, voffA); PG8_STAGE(PG8_SA(0, 1), cA + hstepA, voffA);
    if (wr == 1) PG8_BAR;
    PG8_WAIT_V(2); PG8_BAR;
    PG8_STAGE(PG8_SB(1, 0), cB + kstep, voffB); PG8_STAGE(PG8_SA(1, 0), cA + kstep, voffA); PG8_STAGE(PG8_SB(1, 1), cB + hstepB + kstep, voffB);
    PG8_WAIT_V(6); PG8_BAR;
    for (;;) {
        const bool has_next = S.next(ui + 1, nxt);
        const char* nA = has_next ? PG8_ABASE(nxt.pm) : cA; const char* nB = has_next ? (const char*)g.Bt + (size_t)nxt.pn * tstepB : cB;
        for (int t = 0; t < nt; t += 2) {
            const bool last = (t == nt - 2);
            const char* a1 = cA + (size_t)(t + 1) * kstep;
            const char* a2 = last ? nA : cA + (size_t)(t + 2) * kstep; const char* b2 = last ? nB : cB + (size_t)(t + 2) * kstep;
            const char* a3 = a2 + kstep; const char* b3 = b2 + kstep;
            PG8_LDB(B0, 0, 0); PG8_LDB(B1, 0, 1); PG8_SCHED; PG8_LDA(At, 0, 0); PG8_STAGE(PG8_SA(1, 1), a1 + hstepA, voffA);
            PG8_WAIT_V(8); PG8_WAIT_L(0); PG8_BAR; PG8_MMA(0, 0, At, B0); PG8_MMA(0, 1, At, B1); PG8_BAR; PG8_SCHED;
            PG8_LDA(At, 0, 1); PG8_STAGE(PG8_SB(0, 0), b2, voffB); PG8_STAGE(PG8_SB(0, 1), b2 + hstepB, voffB); PG8_STAGE(PG8_SA(0, 0), a2, voffA);
            PG8_WAIT_V(8); PG8_WAIT_L(0); PG8_BAR; PG8_MMA(1, 0, At, B0); PG8_MMA(1, 1, At, B1); PG8_BAR; PG8_SCHED;
            PG8_LDB(B0, 1, 0); PG8_LDB(B1, 1, 1); PG8_SCHED; PG8_LDA(At, 1, 0); PG8_STAGE(PG8_SA(0, 1), a2 + hstepA, voffA);
            PG8_WAIT_V(8); PG8_WAIT_L(0); PG8_BAR; PG8_MMA(0, 0, At, B0); PG8_MMA(0, 1, At, B1); PG8_BAR; PG8_SCHED;
            PG8_LDA(At, 1, 1); PG8_STAGE(PG8_SB(1, 0), b3, voffB); PG8_STAGE(PG8_SB(1, 1), b3 + hstepB, voffB); PG8_STAGE(PG8_SA(1, 0), a3, voffA);
            PG8_WAIT_V(8); PG8_WAIT_L(0); PG8_BAR; PG8_MMA(1, 0, At, B0); PG8_MMA(1, 1, At, B1); PG8_BAR; PG8_SCHED;
        }
        if (wr == 0) PG8_BAR;
        { int fr_e = fr, fq_e = fq; asm volatile("" : "+v"(fr_e), "+v"(fq_e));
          E(acc, cur, wr, wc, fr_e, fq_e); }
        if (!has_next) break;
#pragma unroll
        for (int a = 0; a < 2; ++a)
#pragma unroll
            for (int b = 0; b < 2; ++b)
#pragma unroll
                for (int m = 0; m < 4; ++m)
#pragma unroll
                    for (int n = 0; n < 2; ++n) acc[a][b][m][n] = (f32x4){0.f, 0.f, 0.f, 0.f};
        cur = nxt; cA = nA; cB = nB; ++ui;
        if (wr == 1) PG8_BAR;
    }
    PG8_WAIT_V(0);
    PG8_BAR;
#undef PG8_SA
#undef PG8_SB
#undef PG8_ABASE
#undef PG8_STAGE
#undef PG8_LDA
#undef PG8_LDB
#undef PG8_MMA
#undef PG8_WAIT_V
#undef PG8_WAIT_L
#undef PG8_BAR
#undef PG8_SCHED
}

typedef f32x4 AccT[2][2][4][2];

struct EpiMain {
    static constexpr bool PERM = true;
    bf16_t* QK; bf16_t* V; bf16_t* O; float* gates; const float* b_gate;
    __device__ __forceinline__ void operator()(const AccT& acc, const Unit& u, int wr, int wc, int fr, int fq) const {
        const int row0 = u.pm * BM + wr * 64 + fr;
        if (u.pn < 6) {
            bf16_t* base = QK + (size_t)(u.pn >> 1) * (size_t)(16u << 20) + (u.pn & 1) * 256 + wc * 32 + 8 * fq;
#pragma unroll
            for (int ai = 0; ai < 2; ++ai)
#pragma unroll
                for (int m = 0; m < 4; ++m) { bf16_t* rowp = base + (size_t)(row0 + ai * HALF + m * 16) * 512;
#pragma unroll
                    for (int bj = 0; bj < 2; ++bj) { const f32x4 v0 = acc[ai][bj][m][0], v1 = acc[ai][bj][m][1];
                        u32x4 w; w.x = cvt_pk_bf16(v0[0], v0[1]); w.y = cvt_pk_bf16(v0[2], v0[3]); w.z = cvt_pk_bf16(v1[0], v1[1]); w.w = cvt_pk_bf16(v1[2], v1[3]);
                        *(u32x4*)(rowp + bj * HALF) = w; } }
        } else if (wc == 0 && fq < 2) {
#pragma unroll
            for (int n = 0; n < 2; ++n) { const int col = 8 * fq + 4 * n; const f32x4 bg = *(const f32x4*)(b_gate + col); const bool isf = (n == 1);
#pragma unroll
                for (int ai = 0; ai < 2; ++ai)
#pragma unroll
                    for (int m = 0; m < 4; ++m) { f32x4 v = acc[ai][0][m][n] + bg;
                        if (isf) { v[0] = log_sigmoid(v[0]); v[1] = log_sigmoid(v[1]); v[2] = log_sigmoid(v[2]); v[3] = log_sigmoid(v[3]); }
                        *(f32x4*)(gates + (size_t)(row0 + ai * HALF + m * 16) * 16 + col) = v; } }
        }
    }
};
struct EpiFF1 {
    static constexpr bool PERM = true;
    bf16_t* Hd; const float* bias;
    __device__ __forceinline__ void operator()(const AccT& acc, const Unit& u, int wr, int wc, int fr, int fq) const {
        const int row0 = u.pm * BM + wr * 64 + fr, col0 = u.pn * BM + wc * 32 + 8 * fq;
        f32x4 bv[2][2];
#pragma unroll
        for (int bj = 0; bj < 2; ++bj)
#pragma unroll
            for (int n = 0; n < 2; ++n) bv[bj][n] = *(const f32x4*)(bias + col0 + bj * HALF + 4 * n);
#pragma unroll
        for (int ai = 0; ai < 2; ++ai)
#pragma unroll
            for (int m = 0; m < 4; ++m) { bf16_t* rowp = Hd + (size_t)(row0 + ai * HALF + m * 16) * FF + col0;
#pragma unroll
                for (int bj = 0; bj < 2; ++bj) { f32x4 v0 = acc[ai][bj][m][0] + bv[bj][0], v1 = acc[ai][bj][m][1] + bv[bj][1];
#pragma unroll
                    for (int j = 0; j < 4; ++j) { const float a = fmaxf(v0[j], 0.f), b = fmaxf(v1[j], 0.f); v0[j] = a * a; v1[j] = b * b; }
                    u32x4 w; w.x = cvt_pk_bf16(v0[0], v0[1]); w.y = cvt_pk_bf16(v0[2], v0[3]); w.z = cvt_pk_bf16(v1[0], v1[1]); w.w = cvt_pk_bf16(v1[2], v1[3]);
                    *(u32x4*)(rowp + bj * HALF) = w; } }
    }
};
struct EpiOut {
    static constexpr bool PERM = true;
    const float* x; bf16_t* U; const float* mod;
    __device__ __forceinline__ void operator()(const AccT& acc, const Unit& u, int wr, int wc, int fr, int fq) const {
        const int row0 = u.pm * BM + wr * 64 + fr, col0 = u.pn * BM + wc * 32 + 8 * fq;
        const float* g1 = mod + (size_t)((u.pm * BM) >> 14) * 6144 + 2048 + col0;
        f32x4 gv[2][2];
#pragma unroll
        for (int bj = 0; bj < 2; ++bj)
#pragma unroll
            for (int n = 0; n < 2; ++n) gv[bj][n] = *(const f32x4*)(g1 + bj * HALF + 4 * n) + 1.0f;
#pragma unroll
        for (int ai = 0; ai < 2; ++ai)
#pragma unroll
            for (int m = 0; m < 4; ++m) { const size_t off = (size_t)(row0 + ai * HALF + m * 16) * DM + col0;
#pragma unroll
                for (int bj = 0; bj < 2; ++bj) { const f32x4 x0 = *(const f32x4*)(x + off + bj * HALF), x1 = *(const f32x4*)(x + off + bj * HALF + 4);
                    const f32x4 v0 = x0 * ALPHA + gv[bj][0] * acc[ai][bj][m][0], v1 = x1 * ALPHA + gv[bj][1] * acc[ai][bj][m][1];
                    u32x4 w; w.x = cvt_pk_bf16(v0[0], v0[1]); w.y = cvt_pk_bf16(v0[2], v0[3]); w.z = cvt_pk_bf16(v1[0], v1[1]); w.w = cvt_pk_bf16(v1[2], v1[3]);
                    *(u32x4*)(U + off + bj * HALF) = w; } }
    }
};
struct EpiFF2 {
    static constexpr bool PERM = true;
    const bf16_t* U; bf16_t* V; const float* mod; const f32x2* st1; const float* ln_g; const float* ln_b; const float* b2;
    __device__ __forceinline__ void operator()(const AccT& acc, const Unit& u, int wr, int wc, int fr, int fq) const {
        const int row0 = u.pm * BM + wr * 64 + fr, col0 = u.pn * BM + wc * 32 + 8 * fq;
        const float* g2 = mod + (size_t)((u.pm * BM) >> 14) * 6144 + 5120 + col0;
#pragma unroll
        for (int bj = 0; bj < 2; ++bj) { const int c = col0 + bj * HALF;
            const f32x4 gv0 = *(const f32x4*)(g2 + bj * HALF) + 1.0f, gv1 = *(const f32x4*)(g2 + bj * HALF + 4) + 1.0f, lg0 = *(const f32x4*)(ln_g + c), lg1 = *(const f32x4*)(ln_g + c + 4),
                        lb0 = *(const f32x4*)(ln_b + c), lb1 = *(const f32x4*)(ln_b + c + 4), bb0 = *(const f32x4*)(b2 + c), bb1 = *(const f32x4*)(b2 + c + 4);
#pragma unroll
            for (int ai = 0; ai < 2; ++ai)
#pragma unroll
                for (int m = 0; m < 4; ++m) { const int r = row0 + ai * HALF + m * 16; const f32x2 s = st1[r]; const size_t off = (size_t)r * DM + c;
                    const u32x4 uw = *(const u32x4*)(U + off);
                    f32x4 u0, u1;
                    u0[0] = __builtin_bit_cast(float, uw.x << 16); u0[1] = __builtin_bit_cast(float, uw.x & 0xffff0000u); u0[2] = __builtin_bit_cast(float, uw.y << 16); u0[3] = __builtin_bit_cast(float, uw.y & 0xffff0000u);
                    u1[0] = __builtin_bit_cast(float, uw.z << 16); u1[1] = __builtin_bit_cast(float, uw.z & 0xffff0000u); u1[2] = __builtin_bit_cast(float, uw.w << 16); u1[3] = __builtin_bit_cast(float, uw.w & 0xffff0000u);
                    const f32x4 xa = (u0 - s.x) * s.y * lg0 + lb0, xb = (u1 - s.x) * s.y * lg1 + lb1;
                    const f32x4 v0 = xa * ALPHA + gv0 * (acc[ai][bj][m][0] + bb0), v1 = xb * ALPHA + gv1 * (acc[ai][bj][m][1] + bb1);
                    u32x4 w; w.x = cvt_pk_bf16(v0[0], v0[1]); w.y = cvt_pk_bf16(v0[2], v0[3]); w.z = cvt_pk_bf16(v1[0], v1[1]); w.w = cvt_pk_bf16(v1[2], v1[3]);
                    *(u32x4*)(V + off) = w; } }
    }
};
struct EpiFold {
    static constexpr bool PERM = true;
    bf16_t* WO;
    __device__ __forceinline__ void operator()(const AccT& acc, const Unit& u, int wr, int wc, int fr, int fq) const {
        const int g = u.pm >> 2, n0 = (u.pm & 3) * 256 + wr * 64 + fr;
        bf16_t* base = WO + 512 + g * 256 + wc * 32 + 8 * fq;
#pragma unroll
        for (int ai = 0; ai < 2; ++ai)
#pragma unroll
            for (int m = 0; m < 4; ++m) { bf16_t* rowp = base + (size_t)(n0 + ai * HALF + m * 16) * KOUT;
#pragma unroll
                for (int bj = 0; bj < 2; ++bj) { const f32x4 v0 = acc[ai][bj][m][0], v1 = acc[ai][bj][m][1];
                    u32x4 w; w.x = cvt_pk_bf16(v0[0], v0[1]); w.y = cvt_pk_bf16(v0[2], v0[3]); w.z = cvt_pk_bf16(v1[0], v1[1]); w.w = cvt_pk_bf16(v1[2], v1[3]);
                    *(u32x4*)(rowp + bj * HALF) = w; } }
    }
};
struct EpiF0 {
    static constexpr bool PERM = false;
    bf16_t* FZ;
    __device__ __forceinline__ void operator()(const AccT& acc, const Unit& u, int wr, int wc, int fr, int fq) const {
        const int b = u.pm >> 6, s20 = (u.pm & 63) * 2;
#pragma unroll
        for (int bj = 0; bj < 2; ++bj)
#pragma unroll
            for (int n = 0; n < 2; ++n) { const int c = u.pn * BM + bj * HALF + wc * 32 + n * 16 + fr;
#pragma unroll
                for (int ai = 0; ai < 2; ++ai)
#pragma unroll
                    for (int m = 0; m < 4; ++m) { const f32x4 v = acc[ai][bj][m][n];
                        u32x2 w; w.x = cvt_pk_bf16(v[0], v[1]); w.y = cvt_pk_bf16(v[2], v[3]);
                        *(u32x2*)(FZ + ((size_t)(b * 512 + c) * 128 + s20 + ai) * 128 + wr * 64 + m * 16 + 4 * fq) = w; } }
    }
};
struct EpiF1 {
    static constexpr bool PERM = false;
    bf16_t* F1O; const f32x2* TW;
    __device__ __forceinline__ void operator()(const AccT& acc, const Unit& u, int wr, int wc, int fr, int fq) const {
#pragma unroll
        for (int n = 0; n < 2; ++n) { const int k1 = wc * 32 + n * 16 + fr;
            const f32x2 w16 = TW[(16 * k1) & 16383];
            f32x2 t[4];
#pragma unroll
            for (int j = 0; j < 4; ++j) t[j] = TW[((wr * 64 + 4 * fq + j) * k1) & 16383];
#pragma unroll
            for (int m = 0; m < 4; ++m) { const int s2 = wr * 64 + m * 16 + 4 * fq;
#pragma unroll
                for (int ai = 0; ai < 2; ++ai) { const int bc = u.pm * 2 + ai, b = bc >> 9, c = bc & 511;
                    bf16_t* dst = F1O + (((size_t)(b * 128 + k1) * 512 + c) * 2) * 128;
                    const f32x4 ar = acc[ai][0][m][n], ai_ = acc[ai][1][m][n];
                    float pr[4], pi[4];
#pragma unroll
                    for (int j = 0; j < 4; ++j) { pr[j] = ar[j] * t[j].x + ai_[j] * t[j].y; pi[j] = ai_[j] * t[j].x - ar[j] * t[j].y; }
                    u32x2 w0, w1; w0.x = cvt_pk_bf16(pr[0], pr[1]); w0.y = cvt_pk_bf16(pr[2], pr[3]); w1.x = cvt_pk_bf16(pi[0], pi[1]); w1.y = cvt_pk_bf16(pi[2], pi[3]);
                    *(u32x2*)(dst + s2) = w0; *(u32x2*)(dst + 128 + s2) = w1; }
#pragma unroll
                for (int j = 0; j < 4; ++j) { const float c = t[j].x * w16.x - t[j].y * w16.y, s = t[j].y * w16.x + t[j].x * w16.y; t[j].x = c; t[j].y = s; }
                asm volatile("" ::: "memory"); } }
    }
};
struct EpiF2 {
    static constexpr bool PERM = false;
    bf16_t* AOUT;
    __device__ __forceinline__ void operator()(const AccT& acc, const Unit& u, int wr, int wc, int fr, int fq) const {
        const int bk = u.pm >> 1, chalf = u.pm & 1, b = bk >> 7, k1 = bk & 127;
#pragma unroll
        for (int bj = 0; bj < 2; ++bj)
#pragma unroll
            for (int n = 0; n < 2; ++n) { const int k2 = wc * 32 + n * 16 + fr; bf16_t* rowp = AOUT + (size_t)(b * SEQ + k1 + 128 * k2) * KOUT + 512 + bj * 128;
#pragma unroll
                for (int ai = 0; ai < 2; ++ai)
#pragma unroll
                    for (int m = 0; m < 4; ++m) { const f32x4 v = acc[ai][bj][m][n];
                        u32x2 w; w.x = cvt_pk_bf16(v[0], v[1]); w.y = cvt_pk_bf16(v[2], v[3]);
                        *(u32x2*)(rowp + (chalf * 2 + ai) * 256 + wr * 64 + m * 16 + 4 * fq) = w; } }
    }
};
}

#define XB_TMO      128
#define XB_XCNT(j)  (256  + 64 * (j))
#define XB_XSUB(j)  (1280 + 64 * (j))
#define XB_XGEN(j)  (2304 + 64 * (j))
#define XB_TOP      3328
#define XB_TOPGEN   3392
#define XCD_BAR_WORDS 3456
#define XB_SPIN_CAP (1u << 18)
__device__ __forceinline__ unsigned xb_ld(unsigned* p)              { return __hip_atomic_load(p, __ATOMIC_RELAXED, __HIP_MEMORY_SCOPE_AGENT); }
__device__ __forceinline__ unsigned xb_add(unsigned* p, unsigned v) { return __hip_atomic_fetch_add(p, v, __ATOMIC_RELAXED, __HIP_MEMORY_SCOPE_AGENT); }
__device__ __forceinline__ unsigned xb_xcc_id() { return (unsigned)__builtin_amdgcn_s_getreg((3 << 11) | 20) & 0xFu; }
#define XB_SPIN(cond, bar) do { unsigned _sp = 0; while (cond) { __builtin_amdgcn_s_sleep(1); \
    if ((++_sp & 255u) == 0u) { if (xb_ld(&(bar)[XB_TMO])) break; if (_sp > XB_SPIN_CAP) { atomicAdd(&(bar)[XB_TMO], 1u); break; } } } } while (0)
struct XcdBarrier { unsigned* bar; unsigned x; volatile LAS unsigned* st; };
__device__ __forceinline__ XcdBarrier xcd_barrier_post(unsigned* bar, volatile LAS unsigned* st) {
    XcdBarrier b; b.bar = bar; b.x = xb_xcc_id(); b.st = st;
    if (threadIdx.x == 0) (void)xb_add(&bar[XB_XCNT(b.x)], 1u);
    return b;
}
__device__ __forceinline__ void xcd_barrier_complete(unsigned* bar, unsigned x, unsigned& nloc, unsigned& nx) {
    const unsigned G = gridDim.x * gridDim.y * gridDim.z;
    unsigned sum, cnt, mine, sp = 0u;
    for (;;) {
        sum = 0u; cnt = 0u; mine = 0u;
#pragma unroll
        for (unsigned j = 0; j < 16; ++j) { const unsigned c = xb_ld(&bar[XB_XCNT(j)]); sum += c; cnt += (c > 0u) ? 1u : 0u; mine = (j == x) ? c : mine; }
        if (sum == G) break;
        __builtin_amdgcn_s_sleep(1);
        if ((++sp & 255u) == 0u) { if (xb_ld(&bar[XB_TMO])) break; if (sp > XB_SPIN_CAP) { atomicAdd(&bar[XB_TMO], 1u); break; } }
    }
    nloc = mine > 0u ? mine : 1u; nx = cnt > 0u ? cnt : 1u;
}
__device__ __forceinline__ void xcd_barrier(const XcdBarrier& b) {
    asm volatile("s_waitcnt vmcnt(0)" ::: "memory");
    __syncthreads();
    if (threadIdx.x == 0) {
        unsigned* bar = b.bar;
        __builtin_amdgcn_s_waitcnt(0);
        unsigned nloc = b.st[0], nx = b.st[1];
        if (nloc == 0u) { xcd_barrier_complete(bar, b.x, nloc, nx); b.st[0] = nloc; b.st[1] = nx; }
        const unsigned old = xb_add(&bar[XB_XSUB(b.x)], 1u);
        const unsigned gen = old / nloc;
        if (old + 1u == (gen + 1u) * nloc) {
            __builtin_amdgcn_fence(__ATOMIC_RELEASE, "agent");
            asm volatile("s_waitcnt vmcnt(0)" ::: "memory");
            const unsigned og = xb_add(&bar[XB_TOP], 1u);
            const unsigned tg = og / nx;
            if (og + 1u == (tg + 1u) * nx) xb_add(&bar[XB_TOPGEN], 1u);
            else XB_SPIN(xb_ld(&bar[XB_TOPGEN]) == tg, bar);
            __builtin_amdgcn_fence(__ATOMIC_ACQUIRE, "agent");
            xb_add(&bar[XB_XGEN(b.x)], 1u);
            asm volatile("s_waitcnt vmcnt(0)" ::: "memory");
        } else {
            XB_SPIN(xb_ld(&bar[XB_XGEN(b.x)]) == gen, bar);
            __builtin_amdgcn_fence(__ATOMIC_ACQUIRE, "agent");
            asm volatile("s_waitcnt vmcnt(0)" ::: "memory");
        }
    }
    __syncthreads();
}

__device__ __forceinline__ void p0_transpose_item(const float* W, int ldsrc, int col0, int nblk, bf16_t* WT, int ldk, int row_off, LAS float* scr, int item, int lane) {
    const int kb = item / nblk, nb = item % nblk, k0 = 64 * kb, n0 = 32 * nb;
#pragma unroll
    for (int i = 0; i < 32; ++i) { const int kk = 2 * i + (lane >> 5); scr[kk * 33 + (lane & 31)] = W[(size_t)(k0 + kk) * ldsrc + col0 + n0 + (lane & 31)]; }
    asm volatile("s_waitcnt lgkmcnt(0)" ::: "memory");
    const int c = lane & 7;
#pragma unroll
    for (int j = 0; j < 4; ++j) { const int n = (lane >> 3) + 8 * j; const LAS float* s = scr + (8 * c) * 33 + n;
        u32x4 o; o.x = pk2(s[0 * 33], s[1 * 33]); o.y = pk2(s[2 * 33], s[3 * 33]); o.z = pk2(s[4 * 33], s[5 * 33]); o.w = pk2(s[6 * 33], s[7 * 33]);
        *(u32x4*)(WT + (size_t)(row_off + n0 + n) * ldk + k0 + 8 * c) = o; }
    asm volatile("s_waitcnt lgkmcnt(0)" ::: "memory");
}

struct Args {
    const float* x; const float* c; const float* w_ada; const float* b_ada; const float* w_in; const float* b_gate; const float* norm_w; const float* w_out;
    const float* ln1_g; const float* ln1_b; const float* w_ff1; const float* b_ff1; const float* w_ff2; const float* b_ff2; const float* ln2_g; const float* ln2_b;
    float* out; unsigned char* ws; int ldw; int pad;
};

#define LDS_BARRIER() do { asm volatile("s_waitcnt lgkmcnt(0)" ::: "memory"); __builtin_amdgcn_s_barrier(); asm volatile("" ::: "memory"); } while (0)
#ifndef PROBE_PH
#define PROBE_PH -1
#endif
#ifndef PROBE_HI
#define PROBE_HI (PROBE_PH + 1)
#endif
#define PROBE_MULT 8
#define STAMP(i) do { if (PROBE_PH >= 0 && blockIdx.x == 0 && threadIdx.x == 0) TS[i] = __builtin_amdgcn_s_memrealtime(); } while (0)
__global__ void __launch_bounds__(512, 2) fwd_kernel(Args a) {
    extern __shared__ __attribute__((aligned(16))) unsigned char lds_raw[];
    LAS unsigned char* lds = (LAS unsigned char*)lds_raw;
    cg::grid_group grid = cg::this_grid();
    const int G = gridDim.x, blk = blockIdx.x, NGW = G * 8, NGT = G * 512;
#define PHASE_IDS() int tid_l = threadIdx.x; asm volatile("" : "+v"(tid_l)); const int tid = tid_l, lane = tid & 63, wave = __builtin_amdgcn_readfirstlane(tid >> 6); \
    const int gw = blk * 8 + wave, gt = blk * 512 + tid; (void)gw; (void)gt; (void)lane; (void)NGW; (void)NGT
#define mod ((float*)(a.ws + WS_MOD))
#define TW ((f32x2*)(a.ws + WS_TW))
#define ST1 ((f32x2*)(a.ws + WS_ST1))
#define MIN ((float*)(a.ws + WS_MIN))
#define SC ((f32x2*)(a.ws + WS_SC))
#define B1 ((bf16_t*)(a.ws + WS_B1))
#define B2 ((bf16_t*)(a.ws + WS_B2))
#define B1F ((bf16_t*)(a.ws + WS_B1F))
#define WTMP ((bf16_t*)(a.ws + WS_WTMP))
#define TS ((unsigned long long*)(a.ws + WS_TS))
#define SCALP ((float*)(a.ws + WS_SCAL))
#define WCAT ((bf16_t*)(a.ws + WS_WCAT))
#define WOUT ((bf16_t*)(a.ws + WS_WOUT))
#define W1 ((bf16_t*)(a.ws + WS_W1))
#define W2 ((bf16_t*)(a.ws + WS_W2))
#define Hb ((bf16_t*)(a.ws + WS_H))
#define QK ((bf16_t*)(a.ws + WS_QK))
#define Vb ((bf16_t*)(a.ws + WS_V))
#define Ob ((bf16_t*)(a.ws + WS_O))
#define GATES ((float*)(a.ws + WS_GATES))
#define FZ ((bf16_t*)(a.ws + WS_FZ))
#define F1O ((bf16_t*)(a.ws + WS_F1O))
#define AOUT ((bf16_t*)(a.ws + WS_AOUT))
#define KVL ((float*)(a.ws + WS_KVL))
#define CST ((bf16_t*)(a.ws + WS_CST))
#define HID ((bf16_t*)(a.ws + WS_HID))
#define U16 ((bf16_t*)(a.ws + WS_U16))
#define V16 ((bf16_t*)(a.ws + WS_H))
    const int ldw = a.ldw;

    STAMP(0);
    if (a.pad != 0) grid.sync();
    if (threadIdx.x < 4) ((LAS unsigned*)(lds + 143360))[threadIdx.x] = 0u;
    __syncthreads();
    const XcdBarrier xbar = xcd_barrier_post((unsigned*)(a.ws + WS_BAR), (volatile LAS unsigned*)(lds + 143360));
    {
        PHASE_IDS();
        if (blk < 192) {
            LAS float* sc = (LAS float*)lds;
            LAS float* red = (LAS float*)(lds + 8192);
            for (int i = tid; i < 2048; i += 512) { const float v = a.c[i]; sc[i] = v / (1.0f + expf(-v)); }
            __syncthreads();
            const int col = lane & 31, par = lane >> 5; float a0 = 0.f, a1 = 0.f;
            const float* wp = a.w_ada + (size_t)(wave * 128 + par) * 6144 + blk * 32 + col;
            float wv[64];
#pragma unroll
            for (int i = 0; i < 64; ++i) wv[i] = wp[(size_t)(2 * i) * 6144];
#pragma unroll
            for (int i = 0; i < 64; ++i) { const int k = wave * 128 + 2 * i + par; a0 += sc[k] * wv[i]; a1 += sc[1024 + k] * wv[i]; }
            a0 += __shfl_xor(a0, 32); a1 += __shfl_xor(a1, 32);
            if (par == 0) { red[(wave * 2 + 0) * 32 + col] = a0; red[(wave * 2 + 1) * 32 + col] = a1; }
            __syncthreads();
            if (tid < 64) { const int b = tid >> 5, l = tid & 31; float s = a.b_ada[blk * 32 + l];
#pragma unroll
                for (int w = 0; w < 8; ++w) s += red[(w * 2 + b) * 32 + l];
                mod[b * 6144 + blk * 32 + l] = s; }
        }
        __syncthreads();
        LAS float* scr = (LAS float*)(lds + wave * 16384);
        constexpr int I_A = 16 * 48, I_B = 16 * 16, I_C = 8 * 32, I_F = 8 * 32, I_D = 16 * 128, I_E = 64 * 32, NITEMS = I_A + I_B + I_C + I_F + I_D + I_E;
        for (int it = gw; it < NITEMS; it += NGW) {
            int r = it;
            if (r < I_A) { p0_transpose_item(a.w_in, ldw, 0, 48, WCAT, DM, 0, scr, r, lane); continue; } r -= I_A;
            if (r < I_B) { p0_transpose_item(a.w_in, ldw, 1536, 16, WCAT, DM, 1792, scr, r, lane); continue; } r -= I_B;
            if (r < I_C) { p0_transpose_item(a.w_out, DM, 0, 32, WOUT, KOUT, 0, scr, r, lane); continue; } r -= I_C;
            if (r < I_F) { p0_transpose_item(a.w_out + (size_t)512 * DM, DM, 0, 32, WTMP, 512, 0, scr, r, lane); continue; } r -= I_F;
            if (r < I_D) { p0_transpose_item(a.w_ff1, FF, 0, 128, W1, DM, 0, scr, r, lane); continue; } r -= I_D;
            p0_transpose_item(a.w_ff2, DM, 0, 32, W2, FF, 0, scr, r, lane);
        }
        for (int i = gt; i < 16 * 1024; i += NGT) { const int gcol = i >> 10, k = i & 1023; WCAT[(size_t)(1536 + gcol) * DM + k] = (bf16_t)f2bf(a.w_in[(size_t)k * ldw + 2048 + gcol]); }
        for (int i = gt; i < 240 * 128; i += NGT) *(u32x4*)(WCAT + (size_t)1552 * DM + (size_t)i * 8) = (u32x4){0u, 0u, 0u, 0u};
        const float isq = 0.08838834764831845f;
        for (int i = gt; i < 256 * 128; i += NGT) { const int n = i >> 7, s1 = i & 127, ri = n >> 7, k1 = n & 127; float s, c; sincospif((float)((k1 * s1) & 127) * (1.0f / 64.0f), &s, &c);
            B1[i] = (bf16_t)f2bf((ri ? -s : c) * isq); B1F[i] = (bf16_t)f2bf((ri ? s : c) * isq); }
        for (int i = gt; i < 256 * 256; i += NGT) { const int n = i >> 8, kk = i & 255, ro = n >> 7, k2 = n & 127, ri = kk >> 7, s2 = kk & 127; float s, c; sincospif((float)((k2 * s2) & 127) * (1.0f / 64.0f), &s, &c);
            const float v = (ro == 0) ? (ri == 0 ? c : s) : (ri == 0 ? -s : c); B2[i] = (bf16_t)f2bf(v * isq); }
        for (int i = gt; i < 16384; i += NGT) { float s, c; sincospif((float)i * (1.0f / 8192.0f), &s, &c); TW[i] = (f32x2){c, s}; }
    }
    xcd_barrier(xbar);
    STAMP(1);

    { PHASE_IDS();
    for (int m0 = gw * 4; m0 < MT; m0 += NGW * 4) {
        f32x4 v[4][4]; LN_LOAD4(v, a.x, m0);
        const float* mb = mod + (size_t)(m0 >> 14) * 6144;
        f32x4 shv[4], scv[4];
#pragma unroll
        for (int j = 0; j < 4; ++j) { shv[j] = ((const f32x4*)mb)[lane + 64 * j]; scv[j] = ((const f32x4*)(mb + 1024))[lane + 64 * j] + 1.0f; }
        float sq[8]; LN_STATS4(v, sq);
#pragma unroll
        for (int r = 0; r < 4; ++r) { u32x2* o8 = (u32x2*)(Hb + (size_t)(m0 + r) * DM) + lane;
#pragma unroll
            for (int j = 0; j < 4; ++j) {
                const f32x4 y = (v[r][j] - sq[r]) * sq[4 + r] * scv[j] + shv[j]; u32x2 w; w.x = pk2(y[0], y[1]); w.y = pk2(y[2], y[3]); o8[64 * j] = w; } }
    }
    }
    xcd_barrier(xbar);
    STAMP(2);

    {
        pg8::Gemm g; g.A = Hb; g.Bt = WCAT + (size_t)1792 * DM; g.M = MT; g.N = 512; g.K = DM; g.lda = 128u * DM * 2u; g.hstep = (size_t)DM * 2; g.tdiv = 64; g.thi = (size_t)SEQ * DM * 2; g.tlo = (size_t)2 * DM * 2;
        pg8::StaticOrder S; S.init(MT, 512, G, blk);
        pg8::EpiF0 E{FZ};
        pg8::gemm_phase<pg8::EpiF0, true>(lds, g, S, E);
    }
    {
        pg8::Gemm g = pg8::std_gemm(Hb, WCAT, MT, 1792, DM);
        pg8::StaticOrder S; S.init(MT, 1792, G, blk);
        pg8::EpiMain E{QK, Vb, Ob, GATES, a.b_gate};
        pg8::gemm_phase<pg8::EpiMain, false>(lds, g, S, E);
    }
    xcd_barrier(xbar);
    STAMP(3);

    {
        pg8::Gemm g = pg8::std_gemm(FZ, B1, NB * 512 * 128, 256, 128);
        pg8::StaticOrder S; S.init(NB * 512 * 128, 256, G, blk);
        pg8::EpiF1 E{F1O, TW};
        pg8::gemm_phase<pg8::EpiF1, true>(lds, g, S, E);
    }
    {
        PHASE_IDS();
        LAS bf16_t* KsT = (LAS bf16_t*)lds;
        LAS bf16_t* VT = (LAS bf16_t*)(lds + 34816);
        LAS float* gl = (LAS float*)(lds + 69632);
        LAS float* gg = (LAS float*)(lds + 69632 + 2048);
        LAS float* wk = (LAS float*)(lds + 69632 + 3072);
        LAS float* aa = (LAS float*)(lds + 69632 + 4096);
        const int fr = lane & 15, fq = lane >> 4, fq8 = fq * 8, fq8x = (fq * 8) ^ 16;
        const int s_st = tid >> 2, q4 = tid & 3, s_sw = s_st ^ (16 * q4);
        float gpre[4]; bf16x8 kpre[2], vpre[4];
#define M1_PREFETCH(u_) do { const int chunk_ = (u_) & 127, h_ = ((u_) >> 7) & 3, b_ = (u_) >> 9; const size_t tok_ = (size_t)b_ * SEQ + chunk_ * 128; \
            if (tid < 128) { _Pragma("unroll") for (int ty = 0; ty < 4; ++ty) gpre[ty] = GATES[(tok_ + tid) * 16 + ty * 4 + h_]; } \
            const bf16_t* kp_ = QK + (tok_ + s_st) * 512 + 256 + h_ * 64 + q4 * 16; kpre[0] = *(const bf16x8*)kp_; kpre[1] = *(const bf16x8*)(kp_ + 8); \
            const bf16_t* vp_ = Vb + (tok_ + s_st) * 512 + h_ * 128 + q4 * 32; _Pragma("unroll") for (int c = 0; c < 4; ++c) vpre[c] = *(const bf16x8*)(vp_ + c * 8); } while (0)
        if (blk < NB * NH * NCHUNK) M1_PREFETCH(blk);
        for (int u = blk; u < NB * NH * NCHUNK; u += G) {
            const int chunk = u & 127, h = (u >> 7) & 3, b = u >> 9;
            const int chain_f = (b * NH + h) * 2;
            float* scal = SCALP + (size_t)u * 768;
            LDS_BARRIER();
            if (tid < 128) {
#pragma unroll
                for (int ty = 0; ty < 4; ++ty) gl[ty * 128 + tid] = gpre[ty];
            }
            LDS_BARRIER();
            if (tid < 128) {
                float bf_ = 0.f, totf = 0.f, br_ = 0.f, totb = 0.f;
#pragma unroll 8
                for (int r4 = 0; r4 < 32; ++r4) { const f32x4 f4 = *(const LAS f32x4*)(gl + 128 + 4 * r4), b4 = *(const LAS f32x4*)(gl + 384 + 4 * r4);
#pragma unroll
                    for (int q = 0; q < 4; ++q) { const int r = 4 * r4 + q; totf += f4[q]; totb += b4[q]; bf_ += (r <= tid) ? f4[q] : 0.f; br_ += (r >= tid) ? b4[q] : 0.f; } }
                const float li_f = gl[tid], li_b = gl[256 + tid];
                gg[tid] = totf - bf_ + li_f; gg[128 + tid] = totb - br_ + li_b;
                aa[tid] = li_f - bf_; aa[128 + tid] = li_b - br_;
                scal[tid] = li_f - bf_; scal[128 + tid] = li_b - br_; scal[512 + tid] = bf_; scal[640 + tid] = br_;
                if (tid == 0) { wk[0] = totf; wk[1] = totb; }
            }
            LDS_BARRIER();
            if (tid < 128) {
                float mlf = -3.0e38f, mlb = -3.0e38f, cmf = -3.0e38f, cmb = -3.0e38f;
#pragma unroll 8
                for (int r4 = 0; r4 < 32; ++r4) { const f32x4 g0 = *(const LAS f32x4*)(gg + 4 * r4), g1 = *(const LAS f32x4*)(gg + 128 + 4 * r4), x0 = *(const LAS f32x4*)(aa + 4 * r4), x1 = *(const LAS f32x4*)(aa + 128 + 4 * r4);
#pragma unroll
                    for (int q = 0; q < 4; ++q) { const int r = 4 * r4 + q; mlf = fmaxf(mlf, g0[q]); mlb = fmaxf(mlb, g1[q]);
                        cmf = (r <= tid) ? fmaxf(cmf, x0[q]) : cmf; cmb = (r >= tid) ? fmaxf(cmb, x1[q]) : cmb; } }
                scal[256 + tid] = cmf; scal[384 + tid] = cmb;
                const float tf = wk[0], tb = wk[1];
                if (tid == 0) { SC[(size_t)chain_f * 128 + chunk] = (f32x2){tf, mlf}; SC[(size_t)(chain_f + 1) * 128 + chunk] = (f32x2){tb, mlb}; }
                gl[tid] = __expf(gg[tid] - mlf); gl[128 + tid] = __expf(gg[128 + tid] - mlb);
            }
            LDS_BARRIER();
            {
                const float wf = gl[s_st], wb = gl[128 + s_st];
#pragma unroll
                for (int j = 0; j < 8; ++j) { const float a0 = bf2f((unsigned short)kpre[0][j]), a1 = bf2f((unsigned short)kpre[1][j]); const int d0 = q4 * 16 + j, d1 = d0 + 8;
                    KsT[d0 * 136 + s_sw] = (bf16_t)f2bf(a0 * wf); KsT[d1 * 136 + s_sw] = (bf16_t)f2bf(a1 * wf);
                    KsT[(64 + d0) * 136 + s_sw] = (bf16_t)f2bf(a0 * wb); KsT[(64 + d1) * 136 + s_sw] = (bf16_t)f2bf(a1 * wb); }
#pragma unroll
                for (int c = 0; c < 4; ++c)
#pragma unroll
                    for (int j = 0; j < 8; ++j) VT[(q4 * 32 + c * 8 + j) * 136 + s_sw] = (bf16_t)vpre[c][j];
            }
            if (u + G < NB * NH * NCHUNK) M1_PREFETCH(u + G);
            LDS_BARRIER();
            {
                f32x4 acc[8];
#pragma unroll
                for (int n = 0; n < 8; ++n) acc[n] = (f32x4){0.f, 0.f, 0.f, 0.f};
#pragma unroll
                for (int ks = 0; ks < 4; ++ks) { const bf16x8 af = *(const LAS bf16x8*)(KsT + (wave * 16 + fr) * 136 + ((ks * 32) ^ (32 * ((wave >> 1) & 1))) + ((wave & 1) ? fq8x : fq8));
#pragma unroll
                    for (int n = 0; n < 8; ++n) { const bf16x8 bfv = *(const LAS bf16x8*)(VT + (n * 16 + fr) * 136 + ((ks * 32) ^ (32 * ((n >> 2) & 1))) + (((n >> 1) & 1) ? fq8x : fq8));
                        acc[n] = __builtin_amdgcn_mfma_f32_16x16x32_bf16(af, bfv, acc[n], 0, 0, 0); } }
                const int dir = wave >> 2, d = (wave & 3) * 16 + 4 * fq;
                float* dst = KVL + ((size_t)(chain_f + dir) * 128 + chunk) * ST_ROW;
#pragma unroll
                for (int n = 0; n < 8; ++n) *(f32x4*)(dst + (n * 16 + fr) * 64 + d) = acc[n];
                if (tid < 128) { float s = 0.f;
#pragma unroll
                    for (int r8 = 0; r8 < 16; ++r8) { const bf16x8 kk = *(const LAS bf16x8*)(KsT + tid * 136 + 8 * r8);
#pragma unroll
                        for (int q = 0; q < 8; ++q) s += bf2f((unsigned short)kk[q]); }
                    KVL[((size_t)(chain_f + (tid >> 6)) * 128 + chunk) * ST_ROW + 128 * 64 + (tid & 63)] = s; }
            }
        }
        LDS_BARRIER();
#undef M1_PREFETCH
    }
    xcd_barrier(xbar);
    STAMP(4);

    { PHASE_IDS();
    if (gt < 16 * (ST_ROW / 2)) {
        const int chain = gt / (ST_ROW / 2), p = gt % (ST_ROW / 2), dir = chain & 1;
        const float* src = KVL + (size_t)chain * 128 * ST_ROW + 2 * p; bf16_t* dst = CST + (size_t)chain * 128 * ST_ROW + 2 * p;
        const f32x2* scp = SC + (size_t)chain * 128; float* mo = MIN + chain * 128;
        float c0 = 0.f, c1 = 0.f, m = 0.f;
        for (int i0 = 0; i0 < 128; i0 += 16) {
            f32x2 kv[16], sc[16];
#pragma unroll
            for (int q = 0; q < 16; ++q) { const int j = dir ? 127 - (i0 + q) : (i0 + q); kv[q] = *(const f32x2*)(src + (size_t)j * ST_ROW); sc[q] = scp[j]; }
#pragma unroll
            for (int q = 0; q < 16; ++q) { const int j = dir ? 127 - (i0 + q) : (i0 + q);
                *(unsigned*)(dst + (size_t)j * ST_ROW) = pk2(c0, c1); if (p == 0) mo[j] = m;
                const float mn = fmaxf(sc[q].x + m, sc[q].y), dec = expf(sc[q].x + m - mn), wl = expf(sc[q].y - mn);
                c0 = dec * c0 + wl * kv[q].x; c1 = dec * c1 + wl * kv[q].y; m = mn; }
        }
    }
    }
    {
        pg8::Gemm g = pg8::std_gemm(F1O, B2, NB * 128 * 512, 256, 256);
        pg8::SplitOrder S{blk, G, (16 * (ST_ROW / 2) + 511) / 512, 512};
        pg8::EpiF2 E{AOUT};
        pg8::gemm_phase<pg8::EpiF2, true, pg8::SplitOrder>(lds, g, S, E);
    }
    {
        pg8::Gemm g; g.A = WTMP; g.Bt = B1F; g.M = 4096; g.N = 256; g.K = 128; g.lda = 1024u; g.hstep = (size_t)128 * 1024; g.tdiv = 4; g.thi = 256; g.tlo = (size_t)256 * 1024;
        pg8::SliceOrder S{blk, G - 16, 16};
        pg8::EpiFold E{WOUT};
        pg8::gemm_phase<pg8::EpiFold, false, pg8::SliceOrder>(lds, g, S, E);
    }
    xcd_barrier(xbar);
    STAMP(5);

    {
        PHASE_IDS();
        LAS bf16_t* Kx = (LAS bf16_t*)lds;
        LAS bf16_t* VT = (LAS bf16_t*)(lds + 20736);
        LAS bf16_t* CfT = (LAS bf16_t*)(lds + 55552);
        LAS bf16_t* CbT = (LAS bf16_t*)(lds + 73984);
        LAS float* sc6 = (LAS float*)(lds + 92416);
        const int fr = lane & 15, fq = lane >> 4;
        const int s_st = tid >> 2, q4 = tid & 3;
        if (tid >= 64 && tid < 64 + 14 * 9) { const int c = tid - 64; *(LAS u32x4*)(Kx + 130 * 72 + c * 8) = (u32x4){0u, 0u, 0u, 0u}; }
        u32x4 kpre[2], cfpre[2], cbpre[2], npre, scpre; bf16x8 vpre[4];
#define M3_PREFETCH(u_) do { const int h_ = (u_) & 3, chunk_ = ((u_) >> 2) & 127, b_ = (u_) >> 9; const size_t tok_ = (size_t)b_ * SEQ + chunk_ * 128; const int cf_ = (b_ * NH + h_) * 2; \
            const bf16_t* cfp_ = CST + ((size_t)cf_ * 128 + chunk_) * ST_ROW; const bf16_t* cbp_ = CST + ((size_t)(cf_ + 1) * 128 + chunk_) * ST_ROW; \
            _Pragma("unroll") for (int i = 0; i < 2; ++i) { const int c = tid + i * 512, s = c >> 3, part = c & 7; \
                kpre[i] = *(const u32x4*)(QK + (tok_ + s) * 512 + 256 + h_ * 64 + part * 8); cfpre[i] = *(const u32x4*)(cfp_ + s * 64 + part * 8); cbpre[i] = *(const u32x4*)(cbp_ + s * 64 + part * 8); } \
            if (tid < 16) npre = *(const u32x4*)(((tid >> 3) ? cbp_ : cfp_) + 128 * 64 + (tid & 7) * 8); \
            if (tid < 192) scpre = *(const u32x4*)(SCALP + (size_t)((b_ * NH + h_) * 128 + chunk_) * 768 + tid * 4); \
            const bf16_t* vp_ = Vb + (tok_ + s_st) * 512 + h_ * 128 + q4 * 32; _Pragma("unroll") for (int c = 0; c < 4; ++c) vpre[c] = *(const bf16x8*)(vp_ + c * 8); } while (0)
        if (blk < NB * NH * NCHUNK) M3_PREFETCH(blk);
        for (int u = blk; u < NB * NH * NCHUNK; u += G) {
            const int h = u & 3, chunk = (u >> 2) & 127, b = u >> 9; const size_t tok0 = (size_t)b * SEQ + chunk * 128;
            const int chain_f = (b * NH + h) * 2;
            LDS_BARRIER();
            const int t = wave * 16 + fr;
            const bf16_t* qp = QK + (tok0 + t) * 512 + h * 64 + fq * 8;
            const bf16x8 q0 = *(const bf16x8*)qp, q1 = *(const bf16x8*)(qp + 32);
            const float m_f = MIN[chain_f * 128 + chunk], m_b = MIN[(chain_f + 1) * 128 + chunk];
            {
#pragma unroll
                for (int i = 0; i < 2; ++i) { const int c = tid + i * 512, s = c >> 3, part = c & 7;
                    *(LAS u32x4*)(Kx + s * 72 + part * 8) = kpre[i]; *(LAS u32x4*)(CfT + s * 72 + part * 8) = cfpre[i]; *(LAS u32x4*)(CbT + s * 72 + part * 8) = cbpre[i]; }
                if (tid < 16) *(LAS u32x4*)(Kx + (128 + (tid >> 3)) * 72 + (tid & 7) * 8) = npre;
                if (tid < 192) *(LAS u32x4*)(sc6 + tid * 4) = scpre;
#pragma unroll
                for (int c = 0; c < 4; ++c)
#pragma unroll
                    for (int j = 0; j < 8; ++j) VT[(q4 * 32 + c * 8 + j) * 136 + (s_st ^ (16 * q4))] = (bf16_t)vpre[c][j];
            }
            LDS_BARRIER();
            if (u + G < NB * NH * NCHUNK) M3_PREFETCH(u + G);
            {
                f32x4 sacc[9];
#pragma unroll
                for (int n = 0; n < 9; ++n) { sacc[n] = (f32x4){0.f, 0.f, 0.f, 0.f};
                    const bf16x8 kf0 = *(const LAS bf16x8*)(Kx + (n * 16 + fr) * 72 + fq * 8), kf1 = *(const LAS bf16x8*)(Kx + (n * 16 + fr) * 72 + 32 + fq * 8);
                    sacc[n] = __builtin_amdgcn_mfma_f32_16x16x32_bf16(kf0, q0, sacc[n], 0, 0, 0);
                    sacc[n] = __builtin_amdgcn_mfma_f32_16x16x32_bf16(kf1, q1, sacc[n], 0, 0, 0); }
                const float qnf = __shfl(sacc[8][0], fr), qnb = __shfl(sacc[8][1], fr);
                const float Mf = fmaxf(m_f, sc6[256 + t]), Mb = fmaxf(m_b, sc6[384 + t]);
                const float wif = __expf(m_f - Mf), wib = __expf(m_b - Mb), flf = __expf(-sc6[512 + t] - Mf), flb = __expf(-sc6[640 + t] - Mb);
                float sumf = 0.f, sumb = 0.f;
#pragma unroll
                for (int n = 0; n < 8; ++n) { const f32x4 af4 = *(const LAS f32x4*)(sc6 + n * 16 + 4 * fq), ab4 = *(const LAS f32x4*)(sc6 + 128 + n * 16 + 4 * fq);
#pragma unroll
                    for (int j = 0; j < 4; ++j) { const int s = n * 16 + 4 * fq + j; const float sv = sacc[n][j];
                        const float wf = (s <= t) ? __expf(af4[j] - Mf) : 0.f, wb = (s >= t) ? __expf(ab4[j] - Mb) : 0.f;
                        sumf += sv * wf; sumb += sv * wb; } }
                sumf += __shfl_xor(sumf, 16); sumf += __shfl_xor(sumf, 32); sumb += __shfl_xor(sumb, 16); sumb += __shfl_xor(sumb, 32);
                const float denf = 0.125f * (sumf + wif * qnf), denb = 0.125f * (sumb + wib * qnb);
                const float rf = 0.125f / fmaxf(fabsf(denf), flf), rb = 0.125f / fmaxf(fabsf(denb), flb);
                bf16x8 pfr[4], qaf[2], qab[2];
#pragma unroll
                for (int ks = 0; ks < 4; ++ks) { float pv[8];
#pragma unroll
                    for (int hh = 0; hh < 2; ++hh) { const int n = 2 * ks + hh; const f32x4 af4 = *(const LAS f32x4*)(sc6 + n * 16 + 4 * fq), ab4 = *(const LAS f32x4*)(sc6 + 128 + n * 16 + 4 * fq);
#pragma unroll
                        for (int j = 0; j < 4; ++j) { const int s = n * 16 + 4 * fq + j;
                            const float wf = (s <= t) ? __expf(af4[j] - Mf) * rf : 0.f, wb = (s >= t) ? __expf(ab4[j] - Mb) * rb : 0.f;
                            pv[hh * 4 + j] = sacc[n][j] * (wf + wb); } }
                    u32x4 w; w.x = pk2(pv[0], pv[1]); w.y = pk2(pv[2], pv[3]); w.z = pk2(pv[4], pv[5]); w.w = pk2(pv[6], pv[7]);
                    pfr[ks] = __builtin_bit_cast(bf16x8, w); }
                const float cfw = rf * wif, cbw = rb * wib;
#pragma unroll
                for (int ks = 0; ks < 2; ++ks) { const bf16x8 qv = ks ? q1 : q0; unsigned tf[4], tb[4];
#pragma unroll
                    for (int j = 0; j < 4; ++j) { const float e0 = bf2f((unsigned short)qv[2 * j]), e1 = bf2f((unsigned short)qv[2 * j + 1]); tf[j] = pk2(e0 * cfw, e1 * cfw); tb[j] = pk2(e0 * cbw, e1 * cbw); }
                    const u32x4 wfv = (u32x4){tf[0], tf[1], tf[2], tf[3]}, wbv = (u32x4){tb[0], tb[1], tb[2], tb[3]};
                    qaf[ks] = __builtin_bit_cast(bf16x8, wfv); qab[ks] = __builtin_bit_cast(bf16x8, wbv); }
                const bf16_t* op = Ob + (tok0 + t) * 512 + h * 128 + 4 * fq;
                bf16x4 ogv[8];
#pragma unroll
                for (int ne = 0; ne < 8; ++ne) ogv[ne] = *(const bf16x4*)(op + ne * 16);
                f32x4 oacc[8];
#pragma unroll
                for (int ne = 0; ne < 8; ++ne) { oacc[ne] = (f32x4){0.f, 0.f, 0.f, 0.f}; const int e = ne * 16 + fr;
#pragma unroll
                    for (int ks = 0; ks < 4; ++ks) { const int sw = 16 * ((ne >> 1) & 3); const bf16x4 lo = *(const LAS bf16x4*)(VT + e * 136 + ((ks * 32) ^ sw) + 4 * fq), hi = *(const LAS bf16x4*)(VT + e * 136 + ((ks * 32 + 16) ^ sw) + 4 * fq);
                        const bf16x8 vf = (bf16x8){lo[0], lo[1], lo[2], lo[3], hi[0], hi[1], hi[2], hi[3]};
                        oacc[ne] = __builtin_amdgcn_mfma_f32_16x16x32_bf16(vf, pfr[ks], oacc[ne], 0, 0, 0); }
#pragma unroll
                    for (int ks = 0; ks < 2; ++ks) { const bf16x8 c1 = *(const LAS bf16x8*)(CfT + e * 72 + ks * 32 + fq * 8), c2 = *(const LAS bf16x8*)(CbT + e * 72 + ks * 32 + fq * 8);
                        oacc[ne] = __builtin_amdgcn_mfma_f32_16x16x32_bf16(c1, qaf[ks], oacc[ne], 0, 0, 0);
                        oacc[ne] = __builtin_amdgcn_mfma_f32_16x16x32_bf16(c2, qab[ks], oacc[ne], 0, 0, 0); } }
                float s1 = 0.f;
#pragma unroll
                for (int ne = 0; ne < 8; ++ne) s1 += (oacc[ne][0] + oacc[ne][1]) + (oacc[ne][2] + oacc[ne][3]);
                s1 += __shfl_xor(s1, 16); s1 += __shfl_xor(s1, 32);
                const float mu = s1 * (1.0f / 128.0f); float s2 = 0.f;
#pragma unroll
                for (int ne = 0; ne < 8; ++ne) { oacc[ne] = oacc[ne] - mu; s2 += (oacc[ne][0] * oacc[ne][0] + oacc[ne][1] * oacc[ne][1]) + (oacc[ne][2] * oacc[ne][2] + oacc[ne][3] * oacc[ne][3]); }
                s2 += __shfl_xor(s2, 16); s2 += __shfl_xor(s2, 32);
                const float rstd = 1.0f / sqrtf(s2 * (1.0f / 128.0f) + LN_EPS);
                bf16_t* yp = AOUT + (tok0 + t) * KOUT + h * 128 + 4 * fq; const float* nw = a.norm_w + h * 128 + 4 * fq;
#pragma unroll
                for (int ne = 0; ne < 8; ++ne) { const f32x4 wv = *(const f32x4*)(nw + ne * 16); float y[4];
#pragma unroll
                    for (int j = 0; j < 4; ++j) { const float og = bf2f((unsigned short)ogv[ne][j]); y[j] = oacc[ne][j] * rstd * wv[j] / (1.0f + __expf(-og)); }
                    u32x2 w; w.x = pk2(y[0], y[1]); w.y = pk2(y[2], y[3]); *(u32x2*)(yp + ne * 16) = w; }
            }
        }
        LDS_BARRIER();
#undef M3_PREFETCH
    }
    xcd_barrier(xbar);
    STAMP(6);

    {
        pg8::Gemm g = pg8::std_gemm(AOUT, WOUT, MT, DM, KOUT);
        pg8::StaticOrder S; S.init(MT, DM, G, blk);
        pg8::EpiOut E{a.x, U16, mod};
        pg8::gemm_phase<pg8::EpiOut, false>(lds, g, S, E);
    }
    xcd_barrier(xbar);
    STAMP(7);

    { PHASE_IDS();
    for (int m0 = gw * 4; m0 < MT; m0 += NGW * 4) {
        f32x4 v[4][4]; LN_LOAD4_BF16(v, U16, m0);
        const float* mb = mod + (size_t)(m0 >> 14) * 6144;
        f32x4 shv[4], scv[4], lgv[4], lbv[4];
#pragma unroll
        for (int j = 0; j < 4; ++j) { shv[j] = LN_PARAM(mb + 3072, j); scv[j] = LN_PARAM(mb + 4096, j) + 1.0f; lgv[j] = LN_PARAM(a.ln1_g, j); lbv[j] = LN_PARAM(a.ln1_b, j); }
        float sq[8]; LN_STATS4(v, sq);
        if (lane < 4) { const float mu_ = lane == 0 ? sq[0] : (lane == 1 ? sq[1] : (lane == 2 ? sq[2] : sq[3])), rs_ = lane == 0 ? sq[4] : (lane == 1 ? sq[5] : (lane == 2 ? sq[6] : sq[7]));
            ST1[m0 + lane] = (f32x2){mu_, rs_}; }
#pragma unroll
        for (int r = 0; r < 4; ++r)
#pragma unroll
            for (int j = 0; j < 4; ++j) v[r][j] = (v[r][j] - sq[r]) * sq[4 + r] * lgv[j] + lbv[j];
        LN_STATS4(v, sq);
#pragma unroll
        for (int r = 0; r < 4; ++r) { bf16_t* orow = Hb + (size_t)(m0 + r) * DM + 8 * lane;
#pragma unroll
            for (int hf = 0; hf < 2; ++hf) { const f32x4 y0 = (v[r][2 * hf] - sq[r]) * sq[4 + r] * scv[2 * hf] + shv[2 * hf], y1 = (v[r][2 * hf + 1] - sq[r]) * sq[4 + r] * scv[2 * hf + 1] + shv[2 * hf + 1];
                u32x4 w; w.x = pk2(y0[0], y0[1]); w.y = pk2(y0[2], y0[3]); w.z = pk2(y1[0], y1[1]); w.w = pk2(y1[2], y1[3]); *(u32x4*)(orow + hf * 512) = w; } }
    }
    }
    xcd_barrier(xbar);
    STAMP(8);

    {
        pg8::Gemm g = pg8::std_gemm(Hb, W1, MT, FF, DM);
        pg8::StaticOrder S; S.init(MT, FF, G, blk);
        pg8::EpiFF1 E{HID, a.b_ff1};
        pg8::gemm_phase<pg8::EpiFF1, false>(lds, g, S, E);
    }
    xcd_barrier(xbar);
    STAMP(9);

    {
        pg8::Gemm g = pg8::std_gemm(HID, W2, MT, DM, FF);
        pg8::StaticOrder S; S.init(MT, DM, G, blk);
        pg8::EpiFF2 E{U16, V16, mod, ST1, a.ln1_g, a.ln1_b, a.b_ff2};
        pg8::gemm_phase<pg8::EpiFF2, false>(lds, g, S, E);
    }
    xcd_barrier(xbar);
    STAMP(10);

    { PHASE_IDS();
    for (int m0 = gw * 4; m0 < MT; m0 += NGW * 4) {
        f32x4 v[4][4]; LN_LOAD4_BF16(v, V16, m0);
        f32x4 lgv[4], lbv[4];
#pragma unroll
        for (int j = 0; j < 4; ++j) { lgv[j] = LN_PARAM(a.ln2_g, j); lbv[j] = LN_PARAM(a.ln2_b, j); }
        float sq[8]; LN_STATS4(v, sq);
#pragma unroll
        for (int r = 0; r < 4; ++r) { float* orow = a.out + (size_t)(m0 + r) * DM + 8 * lane;
#pragma unroll
            for (int j = 0; j < 4; ++j) *(f32x4*)(orow + (j >> 1) * 512 + 4 * (j & 1)) = (v[r][j] - sq[r]) * sq[4 + r] * lgv[j] + lbv[j]; }
    }
    }
    if (PROBE_PH >= 0 && blockIdx.x == 0 && threadIdx.x == 0) {
        const unsigned long long t1 = __builtin_amdgcn_s_memrealtime(); TS[11] = t1;
        const unsigned long long span = (TS[PROBE_HI] - TS[PROBE_PH]) * PROBE_MULT;
        while (__builtin_amdgcn_s_memrealtime() - t1 < span) __builtin_amdgcn_s_sleep(8);
    }
}

extern "C" void kernel_launch(void* const* d_in, const int* in_sizes, int n_in, void* d_out, int out_size, void* d_ws, size_t ws_size, hipStream_t stream) {
    static int grid = 0;
    if (grid == 0) {
        if (n_in != 16 || out_size != MT * DM || ws_size < WS_END) { fprintf(stderr, "kernel_launch: unexpected shapes (n_in %d, out %d, ws %zu)\n", n_in, out_size, ws_size); grid = -1; return; }
        int dev = 0, cus = 0, per_cu = 0;
        hipGetDevice(&dev);
        hipDeviceGetAttribute(&cus, hipDeviceAttributeMultiprocessorCount, dev);
        hipFuncSetAttribute((const void*)fwd_kernel, hipFuncAttributeMaxDynamicSharedMemorySize, LDS_BYTES);
        hipOccupancyMaxActiveBlocksPerMultiprocessor(&per_cu, (const void*)fwd_kernel, 512, LDS_BYTES);
        if (per_cu < 1) per_cu = 1;
        grid = cus * per_cu;
        if (grid > 256) grid = 256;
        (void)hipGetLastError();
    }
    if (grid < 0) return;
    Args a{};
    a.x = (const float*)d_in[0]; a.c = (const float*)d_in[1]; a.w_ada = (const float*)d_in[2]; a.b_ada = (const float*)d_in[3]; a.w_in = (const float*)d_in[4];
    a.b_gate = (const float*)d_in[5]; a.norm_w = (const float*)d_in[6]; a.w_out = (const float*)d_in[7]; a.ln1_g = (const float*)d_in[8]; a.ln1_b = (const float*)d_in[9];
    a.w_ff1 = (const float*)d_in[10]; a.b_ff1 = (const float*)d_in[11]; a.w_ff2 = (const float*)d_in[12]; a.b_ff2 = (const float*)d_in[13]; a.ln2_g = (const float*)d_in[14]; a.ln2_b = (const float*)d_in[15];
    a.out = (float*)d_out; a.ws = (unsigned char*)d_ws; a.ldw = in_sizes[4] / DM; a.pad = 0;
    (void)hipMemsetAsync((char*)d_ws + WS_BAR, 0, XCD_BAR_WORDS * 4, stream);
    void* args[] = {&a};
    hipError_t e = hipLaunchCooperativeKernel((const void*)fwd_kernel, dim3(grid), dim3(512), args, LDS_BYTES, stream);
    if (e != hipSuccess) fprintf(stderr, "cooperative launch failed: %s (grid %d)\n", hipGetErrorString(e), grid);
}
```

```cpp
#include <hip/hip_runtime.h>
#include <hip/hip_cooperative_groups.h>
#include <cstdio>
#include <cstdint>
namespace cg = cooperative_groups;

#define LAS __attribute__((address_space(3)))
typedef unsigned short bf16_t;
typedef short bf16x8 __attribute__((ext_vector_type(8)));
typedef short bf16x4 __attribute__((ext_vector_type(4)));
typedef float f32x4 __attribute__((ext_vector_type(4)));
typedef float f32x2 __attribute__((ext_vector_type(2)));
typedef unsigned u32x4 __attribute__((ext_vector_type(4)));
typedef unsigned u32x2 __attribute__((ext_vector_type(2)));

constexpr int NB = 2, SEQ = 16384, DM = 1024, MT = NB * SEQ, FF = 4096, NH = 4;
constexpr int NCHUNK = 128;
constexpr int NCAT = 2304;
constexpr int KOUT = 1536;
constexpr float LN_EPS = 1e-5f;
constexpr float ALPHA = 1.189207115002721f;
constexpr int ST_ROW = 129 * 64;

constexpr size_t KiB = 1024, MiB = 1u << 20;
constexpr size_t WS_MOD = 0, WS_TW = 64 * KiB, WS_ST1 = 192 * KiB, WS_MIN = 448 * KiB, WS_SC = 456 * KiB, WS_B1 = 512 * KiB, WS_B2 = 576 * KiB;
constexpr size_t WS_SCAL = 26 * MiB;
constexpr size_t WS_B1F = 704 * KiB, WS_TS = 768 * KiB, WS_BAR = 832 * KiB, WS_WTMP = 25 * MiB;
constexpr size_t WS_WCAT = 1 * MiB, WS_WOUT = 6 * MiB, WS_W1 = 9 * MiB, WS_W2 = 17 * MiB;
constexpr size_t WS_H = 32 * MiB;
constexpr size_t WS_QK = 96 * MiB, WS_V = 128 * MiB, WS_O = 160 * MiB, WS_GATES = 192 * MiB, WS_FZ = 194 * MiB, WS_F1O = 226 * MiB, WS_AOUT = 290 * MiB,
                 WS_KVL = 386 * MiB, WS_CST = 452 * MiB, WS_END = 486 * MiB;
constexpr size_t WS_U16 = 386 * MiB;
constexpr size_t WS_HID = 96 * MiB;
constexpr int LDS_BYTES = 147456;

__device__ __forceinline__ unsigned f2bf(float f) { unsigned u = __builtin_bit_cast(unsigned, f); return (u + 0x7fffu + ((u >> 16) & 1u)) >> 16; }
__device__ __forceinline__ unsigned pk2(float lo, float hi) { return f2bf(lo) | (f2bf(hi) << 16); }
__device__ __forceinline__ float bf2f(unsigned short h) { return __builtin_bit_cast(float, (unsigned)h << 16); }
__device__ __forceinline__ float wave_sum(float v) {
#pragma unroll
    for (int o = 1; o < 64; o <<= 1) v += __shfl_xor(v, o);
    return v;
}
__device__ __forceinline__ void wave_sum8(float (&s)[8]) {
#pragma unroll
    for (int o = 1; o < 64; o <<= 1) {
        float t[8];
#pragma unroll
        for (int i = 0; i < 8; ++i) t[i] = __shfl_xor(s[i], o);
#pragma unroll
        for (int i = 0; i < 8; ++i) s[i] += t[i];
    }
}
#define LN_LOAD4(dst, base, m0_) do { _Pragma("unroll") for (int r = 0; r < 4; ++r) { const f32x4* p_ = (const f32x4*)((base) + (size_t)((m0_) + r) * DM) + lane; \
        _Pragma("unroll") for (int j = 0; j < 4; ++j) dst[r][j] = p_[64 * j]; } } while (0)
#define LN_LOAD4_BF16(dst, base, m0_) do { _Pragma("unroll") for (int r = 0; r < 4; ++r) { const bf16_t* p_ = (base) + (size_t)((m0_) + r) * DM + 8 * lane; \
        _Pragma("unroll") for (int hf = 0; hf < 2; ++hf) { const u32x4 w_ = *(const u32x4*)(p_ + hf * 512); \
            dst[r][2 * hf][0] = __builtin_bit_cast(float, w_.x << 16); dst[r][2 * hf][1] = __builtin_bit_cast(float, w_.x & 0xffff0000u); dst[r][2 * hf][2] = __builtin_bit_cast(float, w_.y << 16); dst[r][2 * hf][3] = __builtin_bit_cast(float, w_.y & 0xffff0000u); \
            dst[r][2 * hf + 1][0] = __builtin_bit_cast(float, w_.z << 16); dst[r][2 * hf + 1][1] = __builtin_bit_cast(float, w_.z & 0xffff0000u); dst[r][2 * hf + 1][2] = __builtin_bit_cast(float, w_.w << 16); dst[r][2 * hf + 1][3] = __builtin_bit_cast(float, w_.w & 0xffff0000u); } } } while (0)
#define LN_PARAM(p, j) (*(const f32x4*)((p) + ((j) >> 1) * 512 + 8 * lane + 4 * ((j) & 1)))
#define LN_STATS4(v, sq) do { _Pragma("unroll") for (int r = 0; r < 4; ++r) { float s_ = 0.f, q_ = 0.f; \
        _Pragma("unroll") for (int j = 0; j < 4; ++j) { s_ += (v[r][j][0] + v[r][j][1]) + (v[r][j][2] + v[r][j][3]); \
            q_ += (v[r][j][0] * v[r][j][0] + v[r][j][1] * v[r][j][1]) + (v[r][j][2] * v[r][j][2] + v[r][j][3] * v[r][j][3]); } \
        sq[r] = s_; sq[4 + r] = q_; } wave_sum8(sq); \
        _Pragma("unroll") for (int r = 0; r < 4; ++r) { const float mean_ = sq[r] * (1.f / DM); const float var_ = fmaxf(sq[4 + r] * (1.f / DM) - mean_ * mean_, 0.f); sq[r] = mean_; sq[4 + r] = 1.f / sqrtf(var_ + LN_EPS); } } while (0)
__device__ __forceinline__ float log_sigmoid(float x) { return fminf(x, 0.f) - __logf(1.0f + __expf(-fabsf(x))); }

namespace pg8 {
constexpr int BM = 256, BK = 64, HALF = 128, HTB = HALF * BK * 2, STAGE_BYTES = 8 * HTB, NXCD = 8, WGM = 8;
__host__ __device__ __forceinline__ int lds_byte(int r, int c) { const int st = (r >> 4) * 2 + (c >> 5), rr = r & 15, cc = c & 31, ob = rr * 64 + cc * 2; return st * 1024 + (ob ^ (((ob >> 9) & 1) << 5)); }
__host__ __device__ __forceinline__ void stage_rc(int b, int& R, int& C) { const int st = b / 1024, sb = b % 1024, swz = sb ^ (((sb >> 9) & 1) << 5); R = (st >> 1) * 16 + swz / 64; C = (st & 1) * 32 + (swz % 64) / 2; }
__host__ __device__ __forceinline__ int perm32(int rho) { const int n = rho >> 4, i = rho & 15; return 8 * (i >> 2) + 4 * n + (i & 3); }

struct Unit { int pm, pn; };
struct Gemm { const bf16_t* A; const bf16_t* Bt; int M, N, K; unsigned lda; size_t hstep; int tdiv; size_t thi, tlo; };
__device__ __forceinline__ Gemm std_gemm(const bf16_t* A, const bf16_t* Bt, int M, int N, int K) {
    Gemm g; g.A = A; g.Bt = Bt; g.M = M; g.N = N; g.K = K; g.lda = (unsigned)K * 2u; g.hstep = (size_t)HALF * K * 2; g.tdiv = 1 << 30; g.thi = 0; g.tlo = (size_t)BM * K * 2; return g;
}

struct StaticOrder {
    int nM, nN, nwg, G, c;
    __device__ void init(int M, int N, int G_, int c_) { nM = M / BM; nN = N / BM; nwg = nM * nN; G = G_; c = c_; }
    __device__ bool next(int i, Unit& u) const {
        const long L = (long)i * G + c; if (L >= nwg) return false;
        int wgid = (int)L; { const int q = nwg / NXCD, r = nwg % NXCD, xcd = wgid % NXCD, off = wgid / NXCD; wgid = (xcd < r ? xcd * (q + 1) : r * (q + 1) + (xcd - r) * q) + off; }
        const int nig = WGM * nN, gid = wgid / nig, fm = gid * WGM, gsz = (nM - fm) < WGM ? (nM - fm) : WGM;
        u.pm = fm + ((wgid % nig) % gsz); u.pn = (wgid % nig) / gsz; return true;
    }
};

struct SplitOrder {
    int c, G, nscan, nunits;
    __device__ bool next(int i, Unit& u) const {
        int idx;
        if (c < nscan) { if (i > 0) return false; idx = c; } else { idx = nscan + (c - nscan) + i * (G - nscan); }
        if (idx >= nunits) return false;
        u.pm = idx; u.pn = 0; return true;
    }
};
struct SliceOrder {
    int c, c0, n;
    __device__ bool next(int i, Unit& u) const { if (i > 0 || c < c0 || c >= c0 + n) return false; u.pm = c - c0; u.pn = 0; return true; }
};

__device__ __forceinline__ unsigned cvt_pk_bf16(float lo, float hi) { unsigned r; asm volatile("v_cvt_pk_bf16_f32 %0, %1, %2" : "=v"(r) : "v"(lo), "v"(hi)); return r; }

template <class Epi, bool SWAP, class Sched = StaticOrder>
__device__ __forceinline__ void gemm_phase(LAS unsigned char* lds, const Gemm g, const Sched& S, const Epi& E) {
    int tid_ = threadIdx.x; asm volatile("" : "+v"(tid_));
    const int tid = tid_, wid = __builtin_amdgcn_readfirstlane(tid >> 6), lane = tid & 63, wr = wid >> 2, wc = wid & 3, fr = lane & 15, fq = lane >> 4;
    const int K = g.K, nt = K / BK;
    unsigned voffA[2], voffB[2];
#pragma unroll
    for (int i = 0; i < 2; ++i) { int R, C; stage_rc(tid * 16 + i * 8192, R, C); const int Rb = (Epi::PERM && !SWAP) ? ((R & ~31) + perm32(R & 31)) : R;
        voffA[i] = (unsigned)R * g.lda + (unsigned)C * 2u; voffB[i] = (unsigned)(Rb * K + C) * 2u; }
    const size_t kstep = (size_t)(BK * 2);
    const size_t hstepA = g.hstep;
    const size_t hstepB = (size_t)HALF * K * 2, tstepB = 2 * hstepB;
    const unsigned ldsw = (unsigned)wid * 1024u;
    const int aoff = lds_byte(wr * 64 + fr, fq * 8), boff = lds_byte(wc * 32 + fr, fq * 8);
#define PG8_SA(b, h) (((b) * 2 + (h)) * HTB)
#define PG8_SB(b, h) ((4 + (b) * 2 + (h)) * HTB)
#define PG8_ABASE(pm) ((const char*)g.A + (size_t)((pm) / g.tdiv) * g.thi + (size_t)((pm) % g.tdiv) * g.tlo)
#define PG8_STAGE(bufoff, gbase, voff) do { _Pragma("unroll") for (int _i = 0; _i < 2; ++_i) \
        __builtin_amdgcn_global_load_lds((const unsigned*)((const char*)(gbase) + (voff)[_i]), (LAS unsigned*)(lds + (bufoff) + ldsw + _i * 8192), 16, 0, 0); } while (0)
#define PG8_LDA(dst, b, h) do { _Pragma("unroll") for (int m = 0; m < 4; ++m) _Pragma("unroll") for (int k = 0; k < 2; ++k) dst[m][k] = *(const LAS bf16x8*)(lds + PG8_SA(b, h) + aoff + m * 2048 + k * 1024); } while (0)
#define PG8_LDB(dst, b, h) do { _Pragma("unroll") for (int n = 0; n < 2; ++n) _Pragma("unroll") for (int k = 0; k < 2; ++k) dst[n][k] = *(const LAS bf16x8*)(lds + PG8_SB(b, h) + boff + n * 2048 + k * 1024); } while (0)
#define PG8_MMA(ai, bj, At, Bt) do { __builtin_amdgcn_s_setprio(1); _Pragma("unroll") for (int m = 0; m < 4; ++m) _Pragma("unroll") for (int n = 0; n < 2; ++n) _Pragma("unroll") for (int k = 0; k < 2; ++k) \
        acc[ai][bj][m][n] = SWAP ? __builtin_amdgcn_mfma_f32_16x16x32_bf16(At[m][k], Bt[n][k], acc[ai][bj][m][n], 0, 0, 0) \
                                 : __builtin_amdgcn_mfma_f32_16x16x32_bf16(Bt[n][k], At[m][k], acc[ai][bj][m][n], 0, 0, 0); __builtin_amdgcn_s_setprio(0); } while (0)
#define PG8_WAIT_V(n) asm volatile("s_waitcnt vmcnt(" #n ")" ::: "memory")
#define PG8_WAIT_L(n) asm volatile("s_waitcnt lgkmcnt(" #n ")" ::: "memory")
#define PG8_BAR __builtin_amdgcn_s_barrier()
#define PG8_SCHED __builtin_amdgcn_sched_barrier(0)
    Unit cur, nxt; int ui = 0;
    if (!S.next(0, cur)) return;
    f32x4 acc[2][2][4][2];
#pragma unroll
    for (int a = 0; a < 2; ++a)
#pragma unroll
        for (int b = 0; b < 2; ++b)
#pragma unroll
            for (int m = 0; m < 4; ++m)
#pragma unroll
                for (int n = 0; n < 2; ++n) acc[a][b][m][n] = (f32x4){0.f, 0.f, 0.f, 0.f};
    bf16x8 At[4][2], B0[2][2], B1[2][2];
    const char* cA = PG8_ABASE(cur.pm); const char* cB = (const char*)g.Bt + (size_t)cur.pn * tstepB;
    PG8_STAGE(PG8_SB(0, 0), cB, voffB); PG8_STAGE(PG8_SB(0, 1), cB + hstepB, voffB); PG8_STAGE(PG8_SA(0, 0), cA, voffA); PG8_STAGE(PG8_SA(0, 1), cA + hstepA, voffA);
    if (wr == 1) PG8_BAR;
    PG8_WAIT_V(2); PG8_BAR;
    PG8_STAGE(PG8_SB(1, 0), cB + kstep, voffB); PG8_STAGE(PG8_SA(1, 0), cA + kstep, voffA); PG8_STAGE(PG8_SB(1, 1), cB + hstepB + kstep, voffB);
    PG8_WAIT_V(6); PG8_BAR;
    for (;;) {
        const bool has_next = S.next(ui + 1, nxt);
        const char* nA = has_next ? PG8_ABASE(nxt.pm) : cA; const char* nB = has_next ? (const char*)g.Bt + (size_t)nxt.pn * tstepB : cB;
        for (int t = 0; t < nt; t += 2) {
            const bool last = (t == nt - 2);
            const char* a1 = cA + (size_t)(t + 1) * kstep;
            const char* a2 = last ? nA : cA + (size_t)(t + 2) * kstep; const char* b2 = last ? nB : cB + (size_t)(t + 2) * kstep;
            const char* a3 = a2 + kstep; const char* b3 = b2 + kstep;
            PG8_LDB(B0, 0, 0); PG8_LDB(B1, 0, 1); PG8_SCHED; PG8_LDA(At, 0, 0); PG8_STAGE(PG8_SA(1, 1), a1 + hstepA, voffA);
            PG8_WAIT_V(8); PG8_WAIT_L(0); PG8_BAR; PG8_MMA(0, 0, At, B0); PG8_MMA(0, 1, At, B1); PG8_BAR; PG8_SCHED;
            PG8_LDA(At, 0, 1); PG8_STAGE(PG8_SB(0, 0), b2, voffB); PG8_STAGE(PG8_SB(0, 1), b2 + hstepB, voffB); PG8_STAGE(PG8_SA(0, 0), a2, voffA);
            PG8_WAIT_V(8); PG8_WAIT_L(0); PG8_BAR; PG8_MMA(1, 0, At, B0); PG8_MMA(1, 1, At, B1); PG8_BAR; PG8_SCHED;
            PG8_LDB(B0, 1, 0); PG8_LDB(B1, 1, 1); PG8_SCHED; PG8_LDA(At, 1, 0); PG8_STAGE(PG8_SA(0, 1), a2 + hstepA, voffA);
            PG8_WAIT_V(8); PG8_WAIT_L(0); PG8_BAR; PG8_MMA(0, 0, At, B0); PG8_MMA(0, 1, At, B1); PG8_BAR; PG8_SCHED;
            PG8_LDA(At, 1, 1); PG8_STAGE(PG8_SB(1, 0), b3, voffB); PG8_STAGE(PG8_SB(1, 1), b3 + hstepB, voffB); PG8_STAGE(PG8_SA(1, 0), a3, voffA);
            PG8_WAIT_V(8); PG8_WAIT_L(0); PG8_BAR; PG8_MMA(1, 0, At, B0); PG8_MMA(1, 1, At, B1); PG8_BAR; PG8_SCHED;
        }
        if (wr == 0) PG8_BAR;
        { int fr_e = fr, fq_e = fq; asm volatile("" : "+v"(fr_e), "+v"(fq_e));
          E(acc, cur, wr, wc, fr_e, fq_e); }
        if (!has_next) break;
#pragma unroll
        for (int a = 0; a < 2; ++a)
#pragma unroll
            for (int b = 0; b < 2; ++b)
#pragma unroll
                for (int m = 0; m < 4; ++m)
#pragma unroll
                    for (int n = 0; n < 2; ++n) acc[a][b][m][n] = (f32x4){0.f, 0.f, 0.f, 0.f};
        cur = nxt; cA = nA; cB = nB; ++ui;
        if (wr == 1) PG8_BAR;
    }
    PG8_WAIT_V(0);
    PG8_BAR;
#undef PG8_SA
#undef PG8_SB
#undef PG8_ABASE
#undef PG8_STAGE
#undef PG8_LDA
#undef PG8_LDB
#undef PG8_MMA
#undef PG8_WAIT_V
#undef PG8_WAIT_L
#undef PG8_BAR
#undef PG8_SCHED
}

typedef f32x4 AccT[2][2][4][2];

struct EpiMain {
    static constexpr bool PERM = true;
    bf16_t* QK; bf16_t* V; bf16_t* O; float* gates; const float* b_gate;
    __device__ __forceinline__ void operator()(const AccT& acc, const Unit& u, int wr, int wc, int fr, int fq) const {
        const int row0 = u.pm * BM + wr * 64 + fr;
        if (u.pn < 6) {
            bf16_t* base = QK + (size_t)(u.pn >> 1) * (size_t)(16u << 20) + (u.pn & 1) * 256 + wc * 32 + 8 * fq;
#pragma unroll
            for (int ai = 0; ai < 2; ++ai)
#pragma unroll
                for (int m = 0; m < 4; ++m) { bf16_t* rowp = base + (size_t)(row0 + ai * HALF + m * 16) * 512;
#pragma unroll
                    for (int bj = 0; bj < 2; ++bj) { const f32x4 v0 = acc[ai][bj][m][0], v1 = acc[ai][bj][m][1];
                        u32x4 w; w.x = cvt_pk_bf16(v0[0], v0[1]); w.y = cvt_pk_bf16(v0[2], v0[3]); w.z = cvt_pk_bf16(v1[0], v1[1]); w.w = cvt_pk_bf16(v1[2], v1[3]);
                        *(u32x4*)(rowp + bj * HALF) = w; } }
        } else if (wc == 0 && fq < 2) {
#pragma unroll
            for (int n = 0; n < 2; ++n) { const int col = 8 * fq + 4 * n; const f32x4 bg = *(const f32x4*)(b_gate + col); const bool isf = (n == 1);
#pragma unroll
                for (int ai = 0; ai < 2; ++ai)
#pragma unroll
                    for (int m = 0; m < 4; ++m) { f32x4 v = acc[ai][0][m][n] + bg;
                        if (isf) { v[0] = log_sigmoid(v[0]); v[1] = log_sigmoid(v[1]); v[2] = log_sigmoid(v[2]); v[3] = log_sigmoid(v[3]); }
                        *(f32x4*)(gates + (size_t)(row0 + ai * HALF + m * 16) * 16 + col) = v; } }
        }
    }
};
struct EpiFF1 {
    static constexpr bool PERM = true;
    bf16_t* Hd; const float* bias;
    __device__ __forceinline__ void operator()(const AccT& acc, const Unit& u, int wr, int wc, int fr, int fq) const {
        const int row0 = u.pm * BM + wr * 64 + fr, col0 = u.pn * BM + wc * 32 + 8 * fq;
        f32x4 bv[2][2];
#pragma unroll
        for (int bj = 0; bj < 2; ++bj)
#pragma unroll
            for (int n = 0; n < 2; ++n) bv[bj][n] = *(const f32x4*)(bias + col0 + bj * HALF + 4 * n);
#pragma unroll
        for (int ai = 0; ai < 2; ++ai)
#pragma unroll
            for (int m = 0; m < 4; ++m) { bf16_t* rowp = Hd + (size_t)(row0 + ai * HALF + m * 16) * FF + col0;
#pragma unroll
                for (int bj = 0; bj < 2; ++bj) { f32x4 v0 = acc[ai][bj][m][0] + bv[bj][0], v1 = acc[ai][bj][m][1] + bv[bj][1];
#pragma unroll
                    for (int j = 0; j < 4; ++j) { const float a = fmaxf(v0[j], 0.f), b = fmaxf(v1[j], 0.f); v0[j] = a * a; v1[j] = b * b; }
                    u32x4 w; w.x = cvt_pk_bf16(v0[0], v0[1]); w.y = cvt_pk_bf16(v0[2], v0[3]); w.z = cvt_pk_bf16(v1[0], v1[1]); w.w = cvt_pk_bf16(v1[2], v1[3]);
                    *(u32x4*)(rowp + bj * HALF) = w; } }
    }
};
struct EpiOut {
    static constexpr bool PERM = true;
    const float* x; bf16_t* U; const float* mod;
    __device__ __forceinline__ void operator()(const AccT& acc, const Unit& u, int wr, int wc, int fr, int fq) const {
        const int row0 = u.pm * BM + wr * 64 + fr, col0 = u.pn * BM + wc * 32 + 8 * fq;
        const float* g1 = mod + (size_t)((u.pm * BM) >> 14) * 6144 + 2048 + col0;
        f32x4 gv[2][2];
#pragma unroll
        for (int bj = 0; bj < 2; ++bj)
#pragma unroll
            for (int n = 0; n < 2; ++n) gv[bj][n] = *(const f32x4*)(g1 + bj * HALF + 4 * n) + 1.0f;
#pragma unroll
        for (int ai = 0; ai < 2; ++ai)
#pragma unroll
            for (int m = 0; m < 4; ++m) { const size_t off = (size_t)(row0 + ai * HALF + m * 16) * DM + col0;
#pragma unroll
                for (int bj = 0; bj < 2; ++bj) { const f32x4 x0 = *(const f32x4*)(x + off + bj * HALF), x1 = *(const f32x4*)(x + off + bj * HALF + 4);
                    const f32x4 v0 = x0 * ALPHA + gv[bj][0] * acc[ai][bj][m][0], v1 = x1 * ALPHA + gv[bj][1] * acc[ai][bj][m][1];
                    u32x4 w; w.x = cvt_pk_bf16(v0[0], v0[1]); w.y = cvt_pk_bf16(v0[2], v0[3]); w.z = cvt_pk_bf16(v1[0], v1[1]); w.w = cvt_pk_bf16(v1[2], v1[3]);
                    *(u32x4*)(U + off + bj * HALF) = w; } }
    }
};
struct EpiFF2 {
    static constexpr bool PERM = true;
    const bf16_t* U; bf16_t* V; const float* mod; const f32x2* st1; const float* ln_g; const float* ln_b; const float* b2;
    __device__ __forceinline__ void operator()(const AccT& acc, const Unit& u, int wr, int wc, int fr, int fq) const {
        const int row0 = u.pm * BM + wr * 64 + fr, col0 = u.pn * BM + wc * 32 + 8 * fq;
        const float* g2 = mod + (size_t)((u.pm * BM) >> 14) * 6144 + 5120 + col0;
#pragma unroll
        for (int bj = 0; bj < 2; ++bj) { const int c = col0 + bj * HALF;
            const f32x4 gv0 = *(const f32x4*)(g2 + bj * HALF) + 1.0f, gv1 = *(const f32x4*)(g2 + bj * HALF + 4) + 1.0f, lg0 = *(const f32x4*)(ln_g + c), lg1 = *(const f32x4*)(ln_g + c + 4),
                        lb0 = *(const f32x4*)(ln_b + c), lb1 = *(const f32x4*)(ln_b + c + 4), bb0 = *(const f32x4*)(b2 + c), bb1 = *(const f32x4*)(b2 + c + 4);
#pragma unroll
            for (int ai = 0; ai < 2; ++ai)
#pragma unroll
                for (int m = 0; m < 4; ++m) { const int r = row0 + ai * HALF + m * 16; const f32x2 s = st1[r]; const size_t off = (size_t)r * DM + c;
                    const u32x4 uw = *(const u32x4*)(U + off);
                    f32x4 u0, u1;
                    u0[0] = __builtin_bit_cast(float, uw.x << 16); u0[1] = __builtin_bit_cast(float, uw.x & 0xffff0000u); u0[2] = __builtin_bit_cast(float, uw.y << 16); u0[3] = __builtin_bit_cast(float, uw.y & 0xffff0000u);
                    u1[0] = __builtin_bit_cast(float, uw.z << 16); u1[1] = __builtin_bit_cast(float, uw.z & 0xffff0000u); u1[2] = __builtin_bit_cast(float, uw.w << 16); u1[3] = __builtin_bit_cast(float, uw.w & 0xffff0000u);
                    const f32x4 xa = (u0 - s.x) * s.y * lg0 + lb0, xb = (u1 - s.x) * s.y * lg1 + lb1;
                    const f32x4 v0 = xa * ALPHA + gv0 * (acc[ai][bj][m][0] + bb0), v1 = xb * ALPHA + gv1 * (acc[ai][bj][m][1] + bb1);
                    u32x4 w; w.x = cvt_pk_bf16(v0[0], v0[1]); w.y = cvt_pk_bf16(v0[2], v0[3]); w.z = cvt_pk_bf16(v1[0], v1[1]); w.w = cvt_pk_bf16(v1[2], v1[3]);
                    *(u32x4*)(V + off) = w; } }
    }
};
struct EpiFold {
    static constexpr bool PERM = true;
    bf16_t* WO;
    __device__ __forceinline__ void operator()(const AccT& acc, const Unit& u, int wr, int wc, int fr, int fq) const {
        const int g = u.pm >> 2, n0 = (u.pm & 3) * 256 + wr * 64 + fr;
        bf16_t* base = WO + 512 + g * 256 + wc * 32 + 8 * fq;
#pragma unroll
        for (int ai = 0; ai < 2; ++ai)
#pragma unroll
            for (int m = 0; m < 4; ++m) { bf16_t* rowp = base + (size_t)(n0 + ai * HALF + m * 16) * KOUT;
#pragma unroll
                for (int bj = 0; bj < 2; ++bj) { const f32x4 v0 = acc[ai][bj][m][0], v1 = acc[ai][bj][m][1];
                    u32x4 w; w.x = cvt_pk_bf16(v0[0], v0[1]); w.y = cvt_pk_bf16(v0[2], v0[3]); w.z = cvt_pk_bf16(v1[0], v1[1]); w.w = cvt_pk_bf16(v1[2], v1[3]);
                    *(u32x4*)(rowp + bj * HALF) = w; } }
    }
};
struct EpiF0 {
    static constexpr bool PERM = false;
    bf16_t* FZ;
    __device__ __forceinline__ void operator()(const AccT& acc, const Unit& u, int wr, int wc, int fr, int fq) const {
        const int b = u.pm >> 6, s20 = (u.pm & 63) * 2;
#pragma unroll
        for (int bj = 0; bj < 2; ++bj)
#pragma unroll
            for (int n = 0; n < 2; ++n) { const int c = u.pn * BM + bj * HALF + wc * 32 + n * 16 + fr;
#pragma unroll
                for (int ai = 0; ai < 2; ++ai)
#pragma unroll
                    for (int m = 0; m < 4; ++m) { const f32x4 v = acc[ai][bj][m][n];
                        u32x2 w; w.x = cvt_pk_bf16(v[0], v[1]); w.y = cvt_pk_bf16(v[2], v[3]);
                        *(u32x2*)(FZ + ((size_t)(b * 512 + c) * 128 + s20 + ai) * 128 + wr * 64 + m * 16 + 4 * fq) = w; } }
    }
};
struct EpiF1 {
    static constexpr bool PERM = false;
    bf16_t* F1O; const f32x2* TW;
    __device__ __forceinline__ void operator()(const AccT& acc, const Unit& u, int wr, int wc, int fr, int fq) const {
#pragma unroll
        for (int n = 0; n < 2; ++n) { const int k1 = wc * 32 + n * 16 + fr;
            const f32x2 w16 = TW[(16 * k1) & 16383];
            f32x2 t[4];
#pragma unroll
            for (int j = 0; j < 4; ++j) t[j] = TW[((wr * 64 + 4 * fq + j) * k1) & 16383];
#pragma unroll
            for (int m = 0; m < 4; ++m) { const int s2 = wr * 64 + m * 16 + 4 * fq;
#pragma unroll
                for (int ai = 0; ai < 2; ++ai) { const int bc = u.pm * 2 + ai, b = bc >> 9, c = bc & 511;
                    bf16_t* dst = F1O + (((size_t)(b * 128 + k1) * 512 + c) * 2) * 128;
                    const f32x4 ar = acc[ai][0][m][n], ai_ = acc[ai][1][m][n];
                    float pr[4], pi[4];
#pragma unroll
                    for (int j = 0; j < 4; ++j) { pr[j] = ar[j] * t[j].x + ai_[j] * t[j].y; pi[j] = ai_[j] * t[j].x - ar[j] * t[j].y; }
                    u32x2 w0, w1; w0.x = cvt_pk_bf16(pr[0], pr[1]); w0.y = cvt_pk_bf16(pr[2], pr[3]); w1.x = cvt_pk_bf16(pi[0], pi[1]); w1.y = cvt_pk_bf16(pi[2], pi[3]);
                    *(u32x2*)(dst + s2) = w0; *(u32x2*)(dst + 128 + s2) = w1; }
#pragma unroll
                for (int j = 0; j < 4; ++j) { const float c = t[j].x * w16.x - t[j].y * w16.y, s = t[j].y * w16.x + t[j].x * w16.y; t[j].x = c; t[j].y = s; }
                asm volatile("" ::: "memory"); } }
    }
};
struct EpiF2 {
    static constexpr bool PERM = false;
    bf16_t* AOUT;
    __device__ __forceinline__ void operator()(const AccT& acc, const Unit& u, int wr, int wc, int fr, int fq) const {
        const int bk = u.pm >> 1, chalf = u.pm & 1, b = bk >> 7, k1 = bk & 127;
#pragma unroll
        for (int bj = 0; bj < 2; ++bj)
#pragma unroll
            for (int n = 0; n < 2; ++n) { const int k2 = wc * 32 + n * 16 + fr; bf16_t* rowp = AOUT + (size_t)(b * SEQ + k1 + 128 * k2) * KOUT + 512 + bj * 128;
#pragma unroll
                for (int ai = 0; ai < 2; ++ai)
#pragma unroll
                    for (int m = 0; m < 4; ++m) { const f32x4 v = acc[ai][bj][m][n];
                        u32x2 w; w.x = cvt_pk_bf16(v[0], v[1]); w.y = cvt_pk_bf16(v[2], v[3]);
                        *(u32x2*)(rowp + (chalf * 2 + ai) * 256 + wr * 64 + m * 16 + 4 * fq) = w; } }
    }
};
}

#define XB_TMO      128
#define XB_XCNT(j)  (256  + 64 * (j))
#define XB_XSUB(j)  (1280 + 64 * (j))
#define XB_XGEN(j)  (2304 + 64 * (j))
#define XB_TOP      3328
#define XB_TOPGEN   3392
#define XCD_BAR_WORDS 3456
#define XB_SPIN_CAP (1u << 18)
__device__ __forceinline__ unsigned xb_ld(unsigned* p)              { return __hip_atomic_load(p, __ATOMIC_RELAXED, __HIP_MEMORY_SCOPE_AGENT); }
__device__ __forceinline__ unsigned xb_add(unsigned* p, unsigned v) { return __hip_atomic_fetch_add(p, v, __ATOMIC_RELAXED, __HIP_MEMORY_SCOPE_AGENT); }
__device__ __forceinline__ unsigned xb_xcc_id() { return (unsigned)__builtin_amdgcn_s_getreg((3 << 11) | 20) & 0xFu; }
#define XB_SPIN(cond, bar) do { unsigned _sp = 0; while (cond) { __builtin_amdgcn_s_sleep(1); \
    if ((++_sp & 255u) == 0u) { if (xb_ld(&(bar)[XB_TMO])) break; if (_sp > XB_SPIN_CAP) { atomicAdd(&(bar)[XB_TMO], 1u); break; } } } } while (0)
struct XcdBarrier { unsigned* bar; unsigned x; volatile LAS unsigned* st; };
__device__ __forceinline__ XcdBarrier xcd_barrier_post(unsigned* bar, volatile LAS unsigned* st) {
    XcdBarrier b; b.bar = bar; b.x = xb_xcc_id(); b.st = st;
    if (threadIdx.x == 0) (void)xb_add(&bar[XB_XCNT(b.x)], 1u);
    return b;
}
__device__ __forceinline__ void xcd_barrier_complete(unsigned* bar, unsigned x, unsigned& nloc, unsigned& nx) {
    const unsigned G = gridDim.x * gridDim.y * gridDim.z;
    unsigned sum, cnt, mine, sp = 0u;
    for (;;) {
        sum = 0u; cnt = 0u; mine = 0u;
#pragma unroll
        for (unsigned j = 0; j < 16; ++j) { const unsigned c = xb_ld(&bar[XB_XCNT(j)]); sum += c; cnt += (c > 0u) ? 1u : 0u; mine = (j == x) ? c : mine; }
        if (sum == G) break;
        __builtin_amdgcn_s_sleep(1);
        if ((++sp & 255u) == 0u) { if (xb_ld(&bar[XB_TMO])) break; if (sp > XB_SPIN_CAP) { atomicAdd(&bar[XB_TMO], 1u); break; } }
    }
    nloc = mine > 0u ? mine : 1u; nx = cnt > 0u ? cnt : 1u;
}
__device__ __forceinline__ void xcd_barrier(const XcdBarrier& b) {
    asm volatile("s_waitcnt vmcnt(0)" ::: "memory");
    __syncthreads();
    if (threadIdx.x == 0) {
        unsigned* bar = b.bar;
        __builtin_amdgcn_s_waitcnt(0);
        unsigned nloc = b.st[0], nx = b.st[1];
        if (nloc == 0u) { xcd_barrier_complete(bar, b.x, nloc, nx); b.st[0] = nloc; b.st[1] = nx; }
        const unsigned old = xb_add(&bar[XB_XSUB(b.x)], 1u);
        const unsigned gen = old / nloc;
        if (old + 1u == (gen + 1u) * nloc) {
            __builtin_amdgcn_fence(__ATOMIC_RELEASE, "agent");
            asm volatile("s_waitcnt vmcnt(0)" ::: "memory");
            const unsigned og = xb_add(&bar[XB_TOP], 1u);
            const unsigned tg = og / nx;
            if (og + 1u == (tg + 1u) * nx) xb_add(&bar[XB_TOPGEN], 1u);
            else XB_SPIN(xb_ld(&bar[XB_TOPGEN]) == tg, bar);
            __builtin_amdgcn_fence(__ATOMIC_ACQUIRE, "agent");
            xb_add(&bar[XB_XGEN(b.x)], 1u);
            asm volatile("s_waitcnt vmcnt(0)" ::: "memory");
        } else {
            XB_SPIN(xb_ld(&bar[XB_XGEN(b.x)]) == gen, bar);
            __builtin_amdgcn_fence(__ATOMIC_ACQUIRE, "agent");
            asm volatile("s_waitcnt vmcnt(0)" ::: "memory");
        }
    }
    __syncthreads();
}

__device__ __forceinline__ void p0_transpose_item(const float* W, int ldsrc, int col0, int nblk, bf16_t* WT, int ldk, int row_off, LAS float* scr, int item, int lane) {
    const int kb = item / nblk, nb = item % nblk, k0 = 64 * kb, n0 = 32 * nb;
#pragma unroll
    for (int i = 0; i < 32; ++i) { const int kk = 2 * i + (lane >> 5); scr[kk * 33 + (lane & 31)] = W[(size_t)(k0 + kk) * ldsrc + col0 + n0 + (lane & 31)]; }
    asm volatile("s_waitcnt lgkmcnt(0)" ::: "memory");
    const int c = lane & 7;
#pragma unroll
    for (int j = 0; j < 4; ++j) { const int n = (lane >> 3) + 8 * j; const LAS float* s = scr + (8 * c) * 33 + n;
        u32x4 o; o.x = pk2(s[0 * 33], s[1 * 33]); o.y = pk2(s[2 * 33], s[3 * 33]); o.z = pk2(s[4 * 33], s[5 * 33]); o.w = pk2(s[6 * 33], s[7 * 33]);
        *(u32x4*)(WT + (size_t)(row_off + n0 + n) * ldk + k0 + 8 * c) = o; }
    asm volatile("s_waitcnt lgkmcnt(0)" ::: "memory");
}

struct Args {
    const float* x; const float* c; const float* w_ada; const float* b_ada; const float* w_in; const float* b_gate; const float* norm_w; const float* w_out;
    const float* ln1_g; const float* ln1_b; const float* w_ff1; const float* b_ff1; const float* w_ff2; const float* b_ff2; const float* ln2_g; const float* ln2_b;
    float* out; unsigned char* ws; int ldw; int pad;
};

#define LDS_BARRIER() do { asm volatile("s_waitcnt lgkmcnt(0)" ::: "memory"); __builtin_amdgcn_s_barrier(); asm volatile("" ::: "memory"); } while (0)
#ifndef PROBE_PH
#define PROBE_PH -1
#endif
#ifndef PROBE_HI
#define PROBE_HI (PROBE_PH + 1)
#endif
#define PROBE_MULT 8
#define STAMP(i) do { if (PROBE_PH >= 0 && blockIdx.x == 0 && threadIdx.x == 0) TS[i] = __builtin_amdgcn_s_memrealtime(); } while (0)
__global__ void __launch_bounds__(512, 2) fwd_kernel(Args a) {
    extern __shared__ __attribute__((aligned(16))) unsigned char lds_raw[];
    LAS unsigned char* lds = (LAS unsigned char*)lds_raw;
    cg::grid_group grid = cg::this_grid();
    const int G = gridDim.x, blk = blockIdx.x, NGW = G * 8, NGT = G * 512;
#define PHASE_IDS() int tid_l = threadIdx.x; asm volatile("" : "+v"(tid_l)); const int tid = tid_l, lane = tid & 63, wave = __builtin_amdgcn_readfirstlane(tid >> 6); \
    const int gw = blk * 8 + wave, gt = blk * 512 + tid; (void)gw; (void)gt; (void)lane; (void)NGW; (void)NGT
#define mod ((float*)(a.ws + WS_MOD))
#define TW ((f32x2*)(a.ws + WS_TW))
#define ST1 ((f32x2*)(a.ws + WS_ST1))
#define MIN ((float*)(a.ws + WS_MIN))
#define SC ((f32x2*)(a.ws + WS_SC))
#define B1 ((bf16_t*)(a.ws + WS_B1))
#define B2 ((bf16_t*)(a.ws + WS_B2))
#define B1F ((bf16_t*)(a.ws + WS_B1F))
#define WTMP ((bf16_t*)(a.ws + WS_WTMP))
#define TS ((unsigned long long*)(a.ws + WS_TS))
#define SCALP ((float*)(a.ws + WS_SCAL))
#define WCAT ((bf16_t*)(a.ws + WS_WCAT))
#define WOUT ((bf16_t*)(a.ws + WS_WOUT))
#define W1 ((bf16_t*)(a.ws + WS_W1))
#define W2 ((bf16_t*)(a.ws + WS_W2))
#define Hb ((bf16_t*)(a.ws + WS_H))
#define QK ((bf16_t*)(a.ws + WS_QK))
#define Vb ((bf16_t*)(a.ws + WS_V))
#define Ob ((bf16_t*)(a.ws + WS_O))
#define GATES ((float*)(a.ws + WS_GATES))
#define FZ ((bf16_t*)(a.ws + WS_FZ))
#define F1O ((bf16_t*)(a.ws + WS_F1O))
#define AOUT ((bf16_t*)(a.ws + WS_AOUT))
#define KVL ((float*)(a.ws + WS_KVL))
#define CST ((bf16_t*)(a.ws + WS_CST))
#define HID ((bf16_t*)(a.ws + WS_HID))
#define U16 ((bf16_t*)(a.ws + WS_U16))
#define V16 ((bf16_t*)(a.ws + WS_H))
    const int ldw = a.ldw;

    STAMP(0);
    if (a.pad != 0) grid.sync();
    if (threadIdx.x < 4) ((LAS unsigned*)(lds + 143360))[threadIdx.x] = 0u;
    __syncthreads();
    const XcdBarrier xbar = xcd_barrier_post((unsigned*)(a.ws + WS_BAR), (volatile LAS unsigned*)(lds + 143360));
    {
        PHASE_IDS();
        if (blk < 192) {
            LAS float* sc = (LAS float*)lds;
            LAS float* red = (LAS float*)(lds + 8192);
            for (int i = tid; i < 2048; i += 512) { const float v = a.c[i]; sc[i] = v / (1.0f + expf(-v)); }
            __syncthreads();
            const int col = lane & 31, par = lane >> 5; float a0 = 0.f, a1 = 0.f;
            const float* wp = a.w_ada + (size_t)(wave * 128 + par) * 6144 + blk * 32 + col;
            float wv[64];
#pragma unroll
            for (int i = 0; i < 64; ++i) wv[i] = wp[(size_t)(2 * i) * 6144];
#pragma unroll
            for (int i = 0; i < 64; ++i) { const int k = wave * 128 + 2 * i + par; a0 += sc[k] * wv[i]; a1 += sc[1024 + k] * wv[i]; }
            a0 += __shfl_xor(a0, 32); a1 += __shfl_xor(a1, 32);
            if (par == 0) { red[(wave * 2 + 0) * 32 + col] = a0; red[(wave * 2 + 1) * 32 + col] = a1; }
            __syncthreads();
            if (tid < 64) { const int b = tid >> 5, l = tid & 31; float s = a.b_ada[blk * 32 + l];
#pragma unroll
                for (int w = 0; w < 8; ++w) s += red[(w * 2 + b) * 32 + l];
                mod[b * 6144 + blk * 32 + l] = s; }
        }
        __syncthreads();
        LAS float* scr = (LAS float*)(lds + wave * 16384);
        constexpr int I_A = 16 * 48, I_B = 16 * 16, I_C = 8 * 32, I_F = 8 * 32, I_D = 16 * 128, I_E = 64 * 32, NITEMS = I_A + I_B + I_C + I_F + I_D + I_E;
        for (int it = gw; it < NITEMS; it += NGW) {
            int r = it;
            if (r < I_A) { p0_transpose_item(a.w_in, ldw, 0, 48, WCAT, DM, 0, scr, r, lane); continue; } r -= I_A;
            if (r < I_B) { p0_transpose_item(a.w_in, ldw, 1536, 16, WCAT, DM, 1792, scr, r, lane); continue; } r -= I_B;
            if (r < I_C) { p0_transpose_item(a.w_out, DM, 0, 32, WOUT, KOUT, 0, scr, r, lane); continue; } r -= I_C;
            if (r < I_F) { p0_transpose_item(a.w_out + (size_t)512 * DM, DM, 0, 32, WTMP, 512, 0, scr, r, lane); continue; } r -= I_F;
            if (r < I_D) { p0_transpose_item(a.w_ff1, FF, 0, 128, W1, DM, 0, scr, r, lane); continue; } r -= I_D;
            p0_transpose_item(a.w_ff2, DM, 0, 32, W2, FF, 0, scr, r, lane);
        }
        for (int i = gt; i < 16 * 1024; i += NGT) { const int gcol = i >> 10, k = i & 1023; WCAT[(size_t)(1536 + gcol) * DM + k] = (bf16_t)f2bf(a.w_in[(size_t)k * ldw + 2048 + gcol]); }
        for (int i = gt; i < 240 * 128; i += NGT) *(u32x4*)(WCAT + (size_t)1552 * DM + (size_t)i * 8) = (u32x4){0u, 0u, 0u, 0u};
        const float isq = 0.08838834764831845f;
        for (int i = gt; i < 256 * 128; i += NGT) { const int n = i >> 7, s1 = i & 127, ri = n >> 7, k1 = n & 127; float s, c; sincospif((float)((k1 * s1) & 127) * (1.0f / 64.0f), &s, &c);
            B1[i] = (bf16_t)f2bf((ri ? -s : c) * isq); B1F[i] = (bf16_t)f2bf((ri ? s : c) * isq); }
        for (int i = gt; i < 256 * 256; i += NGT) { const int n = i >> 8, kk = i & 255, ro = n >> 7, k2 = n & 127, ri = kk >> 7, s2 = kk & 127; float s, c; sincospif((float)((k2 * s2) & 127) * (1.0f / 64.0f), &s, &c);
            const float v = (ro == 0) ? (ri == 0 ? c : s) : (ri == 0 ? -s : c); B2[i] = (bf16_t)f2bf(v * isq); }
        for (int i = gt; i < 16384; i += NGT) { float s, c; sincospif((float)i * (1.0f / 8192.0f), &s, &c); TW[i] = (f32x2){c, s}; }
    }
    xcd_barrier(xbar);
    STAMP(1);

    { PHASE_IDS();
    for (int m0 = gw * 4; m0 < MT; m0 += NGW * 4) {
        f32x4 v[4][4]; LN_LOAD4(v, a.x, m0);
        const float* mb = mod + (size_t)(m0 >> 14) * 6144;
        f32x4 shv[4], scv[4];
#pragma unroll
        for (int j = 0; j < 4; ++j) { shv[j] = ((const f32x4*)mb)[lane + 64 * j]; scv[j] = ((const f32x4*)(mb + 1024))[lane + 64 * j] + 1.0f; }
        float sq[8]; LN_STATS4(v, sq);
#pragma unroll
        for (int r = 0; r < 4; ++r) { u32x2* o8 = (u32x2*)(Hb + (size_t)(m0 + r) * DM) + lane;
#pragma unroll
            for (int j = 0; j < 4; ++j) {
                const f32x4 y = (v[r][j] - sq[r]) * sq[4 + r] * scv[j] + shv[j]; u32x2 w; w.x = pk2(y[0], y[1]); w.y = pk2(y[2], y[3]); o8[64 * j] = w; } }
    }
    }
    xcd_barrier(xbar);
    STAMP(2);

    {
        pg8::Gemm g; g.A = Hb; g.Bt = WCAT + (size_t)1792 * DM; g.M = MT; g.N = 512; g.K = DM; g.lda = 128u * DM * 2u; g.hstep = (size_t)DM * 2; g.tdiv = 64; g.thi = (size_t)SEQ * DM * 2; g.tlo = (size_t)2 * DM * 2;
        pg8::StaticOrder S; S.init(MT, 512, G, blk);
        pg8::EpiF0 E{FZ};
        pg8::gemm_phase<pg8::EpiF0, true>(lds, g, S, E);
    }
    {
        pg8::Gemm g = pg8::std_gemm(Hb, WCAT, MT, 1792, DM);
        pg8::StaticOrder S; S.init(MT, 1792, G, blk);
        pg8::EpiMain E{QK, Vb, Ob, GATES, a.b_gate};
        pg8::gemm_phase<pg8::EpiMain, false>(lds, g, S, E);
    }
    xcd_barrier(xbar);
    STAMP(3);

    {
        pg8::Gemm g = pg8::std_gemm(FZ, B1, NB * 512 * 128, 256, 128);
        pg8::StaticOrder S; S.init(NB * 512 * 128, 256, G, blk);
        pg8::EpiF1 E{F1O, TW};
        pg8::gemm_phase<pg8::EpiF1, true>(lds, g, S, E);
    }
    {
        PHASE_IDS();
        LAS bf16_t* KsT = (LAS bf16_t*)lds;
        LAS bf16_t* VT = (LAS bf16_t*)(lds + 34816);
        LAS float* gl = (LAS float*)(lds + 69632);
        LAS float* gg = (LAS float*)(lds + 69632 + 8192);
        LAS float* aa = (LAS float*)(lds + 69632 + 12288);
        LAS float* wkA = (LAS float*)(lds + 69632 + 16384);
        LAS float* tot = (LAS float*)(lds + 69632 + 20480);
        const int fr = lane & 15, fq = lane >> 4, fq8 = fq * 8, fq8x = (fq * 8) ^ 16;
        const int s_st = tid >> 2, q4 = tid & 3, s_sw = s_st ^ (16 * q4);
        bf16x8 kpre[2], vpre[4];
#define M1_PREFETCH(u_) do { const int chunk_ = (u_) & 127, h_ = ((u_) >> 7) & 3, b_ = (u_) >> 9; const size_t tok_ = (size_t)b_ * SEQ + chunk_ * 128; \
            const bf16_t* kp_ = QK + (tok_ + s_st) * 512 + 256 + h_ * 64 + q4 * 16; kpre[0] = *(const bf16x8*)kp_; kpre[1] = *(const bf16x8*)(kp_ + 8); \
            const bf16_t* vp_ = Vb + (tok_ + s_st) * 512 + h_ * 128 + q4 * 32; _Pragma("unroll") for (int c = 0; c < 4; ++c) vpre[c] = *(const bf16x8*)(vp_ + c * 8); } while (0)
        for (int ub = blk; ub < NB * NH * NCHUNK; ub += 4 * G) {
            M1_PREFETCH(ub);
            const int ui = tid >> 7, tp = tid & 127, ua = ub + ui * G; const bool ua_ok = ua < NB * NH * NCHUNK;
            LAS float* gl_u = gl + ui * 512; LAS float* gg_u = gg + ui * 256; LAS float* aa_u = aa + ui * 256;
            LDS_BARRIER();
            if (ua_ok) { const int chunk_ = ua & 127, h_ = (ua >> 7) & 3, b_ = ua >> 9; const size_t tok_ = (size_t)b_ * SEQ + chunk_ * 128;
#pragma unroll
                for (int ty = 0; ty < 4; ++ty) gl_u[ty * 128 + tp] = GATES[(tok_ + tp) * 16 + ty * 4 + h_]; }
            LDS_BARRIER();
            if (ua_ok) {
                float* scal = SCALP + (size_t)ua * 768;
                float bf_ = 0.f, totf = 0.f, br_ = 0.f, totb = 0.f;
#pragma unroll 8
                for (int r4 = 0; r4 < 32; ++r4) { const f32x4 f4 = *(const LAS f32x4*)(gl_u + 128 + 4 * r4), b4 = *(const LAS f32x4*)(gl_u + 384 + 4 * r4);
#pragma unroll
                    for (int q = 0; q < 4; ++q) { const int r = 4 * r4 + q; totf += f4[q]; totb += b4[q]; bf_ += (r <= tp) ? f4[q] : 0.f; br_ += (r >= tp) ? b4[q] : 0.f; } }
                const float li_f = gl_u[tp], li_b = gl_u[256 + tp];
                gg_u[tp] = totf - bf_ + li_f; gg_u[128 + tp] = totb - br_ + li_b;
                aa_u[tp] = li_f - bf_; aa_u[128 + tp] = li_b - br_;
                scal[tp] = li_f - bf_; scal[128 + tp] = li_b - br_; scal[512 + tp] = bf_; scal[640 + tp] = br_;
                if (tp == 0) { tot[ui * 2] = totf; tot[ui * 2 + 1] = totb; }
            }
            LDS_BARRIER();
            if (ua_ok) {
                float* scal = SCALP + (size_t)ua * 768;
                float mlf = -3.0e38f, mlb = -3.0e38f, cmf = -3.0e38f, cmb = -3.0e38f;
#pragma unroll 8
                for (int r4 = 0; r4 < 32; ++r4) { const f32x4 g0 = *(const LAS f32x4*)(gg_u + 4 * r4), g1 = *(const LAS f32x4*)(gg_u + 128 + 4 * r4), x0 = *(const LAS f32x4*)(aa_u + 4 * r4), x1 = *(const LAS f32x4*)(aa_u + 128 + 4 * r4);
#pragma unroll
                    for (int q = 0; q < 4; ++q) { const int r = 4 * r4 + q; mlf = fmaxf(mlf, g0[q]); mlb = fmaxf(mlb, g1[q]);
                        cmf = (r <= tp) ? fmaxf(cmf, x0[q]) : cmf; cmb = (r >= tp) ? fmaxf(cmb, x1[q]) : cmb; } }
                scal[256 + tp] = cmf; scal[384 + tp] = cmb;
                if (tp == 0) { const int chunk_ = ua & 127, cf_ = (((ua >> 9) * NH) + ((ua >> 7) & 3)) * 2;
                    SC[(size_t)cf_ * 128 + chunk_] = (f32x2){tot[ui * 2], mlf}; SC[(size_t)(cf_ + 1) * 128 + chunk_] = (f32x2){tot[ui * 2 + 1], mlb}; }
                wkA[ui * 256 + tp] = __expf(gg_u[tp] - mlf); wkA[ui * 256 + 128 + tp] = __expf(gg_u[128 + tp] - mlb);
            }
            LDS_BARRIER();
            for (int i = 0; i < 4; ++i) {
                const int u = ub + i * G; if (u >= NB * NH * NCHUNK) break;
                const int chunk = u & 127, h = (u >> 7) & 3, b = u >> 9;
                const int chain_f = (b * NH + h) * 2;
                {
                    const float wf = wkA[i * 256 + s_st], wb = wkA[i * 256 + 128 + s_st];
#pragma unroll
                    for (int j = 0; j < 8; ++j) { const float a0 = bf2f((unsigned short)kpre[0][j]), a1 = bf2f((unsigned short)kpre[1][j]); const int d0 = q4 * 16 + j, d1 = d0 + 8;
                        KsT[d0 * 136 + s_sw] = (bf16_t)f2bf(a0 * wf); KsT[d1 * 136 + s_sw] = (bf16_t)f2bf(a1 * wf);
                        KsT[(64 + d0) * 136 + s_sw] = (bf16_t)f2bf(a0 * wb); KsT[(64 + d1) * 136 + s_sw] = (bf16_t)f2bf(a1 * wb); }
#pragma unroll
                    for (int c = 0; c < 4; ++c)
#pragma unroll
                        for (int j = 0; j < 8; ++j) VT[(q4 * 32 + c * 8 + j) * 136 + s_sw] = (bf16_t)vpre[c][j];
                }
                if (i < 3 && u + G < NB * NH * NCHUNK) M1_PREFETCH(u + G);
                LDS_BARRIER();
                {
                    f32x4 acc[8];
#pragma unroll
                    for (int n = 0; n < 8; ++n) acc[n] = (f32x4){0.f, 0.f, 0.f, 0.f};
#pragma unroll
                    for (int ks = 0; ks < 4; ++ks) { const bf16x8 af = *(const LAS bf16x8*)(KsT + (wave * 16 + fr) * 136 + ((ks * 32) ^ (32 * ((wave >> 1) & 1))) + ((wave & 1) ? fq8x : fq8));
#pragma unroll
                        for (int n = 0; n < 8; ++n) { const bf16x8 bfv = *(const LAS bf16x8*)(VT + (n * 16 + fr) * 136 + ((ks * 32) ^ (32 * ((n >> 2) & 1))) + (((n >> 1) & 1) ? fq8x : fq8));
                            acc[n] = __builtin_amdgcn_mfma_f32_16x16x32_bf16(af, bfv, acc[n], 0, 0, 0); } }
                    const int dir = wave >> 2, d = (wave & 3) * 16 + 4 * fq;
                    float* dst = KVL + ((size_t)(chain_f + dir) * 128 + chunk) * ST_ROW;
#pragma unroll
                    for (int n = 0; n < 8; ++n) *(f32x4*)(dst + (n * 16 + fr) * 64 + d) = acc[n];
                    if (tid < 128) { float s = 0.f;
#pragma unroll
                        for (int r8 = 0; r8 < 16; ++r8) { const bf16x8 kk = *(const LAS bf16x8*)(KsT + tid * 136 + 8 * r8);
#pragma unroll
                            for (int q = 0; q < 8; ++q) s += bf2f((unsigned short)kk[q]); }
                        KVL[((size_t)(chain_f + (tid >> 6)) * 128 + chunk) * ST_ROW + 128 * 64 + (tid & 63)] = s; }
                }
                LDS_BARRIER();
            }
        }
#undef M1_PREFETCH
    }
    xcd_barrier(xbar);
    STAMP(4);

    { PHASE_IDS();
    if (gt < 16 * (ST_ROW / 2)) {
        const int chain = gt / (ST_ROW / 2), p = gt % (ST_ROW / 2), dir = chain & 1;
        const float* src = KVL + (size_t)chain * 128 * ST_ROW + 2 * p; bf16_t* dst = CST + (size_t)chain * 128 * ST_ROW + 2 * p;
        const f32x2* scp = SC + (size_t)chain * 128; float* mo = MIN + chain * 128;
        float c0 = 0.f, c1 = 0.f, m = 0.f;
        for (int i0 = 0; i0 < 128; i0 += 16) {
            f32x2 kv[16], sc[16];
#pragma unroll
            for (int q = 0; q < 16; ++q) { const int j = dir ? 127 - (i0 + q) : (i0 + q); kv[q] = *(const f32x2*)(src + (size_t)j * ST_ROW); sc[q] = scp[j]; }
#pragma unroll
            for (int q = 0; q < 16; ++q) { const int j = dir ? 127 - (i0 + q) : (i0 + q);
                *(unsigned*)(dst + (size_t)j * ST_ROW) = pk2(c0, c1); if (p == 0) mo[j] = m;
                const float mn = fmaxf(sc[q].x + m, sc[q].y), dec = expf(sc[q].x + m - mn), wl = expf(sc[q].y - mn);
                c0 = dec * c0 + wl * kv[q].x; c1 = dec * c1 + wl * kv[q].y; m = mn; }
        }
    }
    }
    {
        pg8::Gemm g = pg8::std_gemm(F1O, B2, NB * 128 * 512, 256, 256);
        pg8::SplitOrder S{blk, G, (16 * (ST_ROW / 2) + 511) / 512, 512};
        pg8::EpiF2 E{AOUT};
        pg8::gemm_phase<pg8::EpiF2, true, pg8::SplitOrder>(lds, g, S, E);
    }
    {
        pg8::Gemm g; g.A = WTMP; g.Bt = B1F; g.M = 4096; g.N = 256; g.K = 128; g.lda = 1024u; g.hstep = (size_t)128 * 1024; g.tdiv = 4; g.thi = 256; g.tlo = (size_t)256 * 1024;
        pg8::SliceOrder S{blk, G - 16, 16};
        pg8::EpiFold E{WOUT};
        pg8::gemm_phase<pg8::EpiFold, false, pg8::SliceOrder>(lds, g, S, E);
    }
    xcd_barrier(xbar);
    STAMP(5);

    {
        PHASE_IDS();
        LAS bf16_t* Kx = (LAS bf16_t*)lds;
        LAS bf16_t* VT = (LAS bf16_t*)(lds + 20736);
        LAS bf16_t* CfT = (LAS bf16_t*)(lds + 55552);
        LAS bf16_t* CbT = (LAS bf16_t*)(lds + 73984);
        LAS float* sc6 = (LAS float*)(lds + 92416);
        const int fr = lane & 15, fq = lane >> 4;
        const int s_st = tid >> 2, q4 = tid & 3;
        if (tid >= 64 && tid < 64 + 14 * 9) { const int c = tid - 64; *(LAS u32x4*)(Kx + 130 * 72 + c * 8) = (u32x4){0u, 0u, 0u, 0u}; }
        u32x4 kpre[2], cfpre[2], cbpre[2], npre, scpre; bf16x8 vpre[4];
#define M3_PREFETCH(u_) do { const int h_ = (u_) & 3, chunk_ = ((u_) >> 2) & 127, b_ = (u_) >> 9; const size_t tok_ = (size_t)b_ * SEQ + chunk_ * 128; const int cf_ = (b_ * NH + h_) * 2; \
            const bf16_t* cfp_ = CST + ((size_t)cf_ * 128 + chunk_) * ST_ROW; const bf16_t* cbp_ = CST + ((size_t)(cf_ + 1) * 128 + chunk_) * ST_ROW; \
            _Pragma("unroll") for (int i = 0; i < 2; ++i) { const int c = tid + i * 512, s = c >> 3, part = c & 7; \
                kpre[i] = *(const u32x4*)(QK + (tok_ + s) * 512 + 256 + h_ * 64 + part * 8); cfpre[i] = *(const u32x4*)(cfp_ + s * 64 + part * 8); cbpre[i] = *(const u32x4*)(cbp_ + s * 64 + part * 8); } \
            if (tid < 16) npre = *(const u32x4*)(((tid >> 3) ? cbp_ : cfp_) + 128 * 64 + (tid & 7) * 8); \
            if (tid < 192) scpre = *(const u32x4*)(SCALP + (size_t)((b_ * NH + h_) * 128 + chunk_) * 768 + tid * 4); \
            const bf16_t* vp_ = Vb + (tok_ + s_st) * 512 + h_ * 128 + q4 * 32; _Pragma("unroll") for (int c = 0; c < 4; ++c) vpre[c] = *(const bf16x8*)(vp_ + c * 8); } while (0)
        if (blk < NB * NH * NCHUNK) M3_PREFETCH(blk);
        for (int u = blk; u < NB * NH * NCHUNK; u += G) {
            const int h = u & 3, chunk = (u >> 2) & 127, b = u >> 9; const size_t tok0 = (size_t)b * SEQ + chunk * 128;
            const int chain_f = (b * NH + h) * 2;
            LDS_BARRIER();
            const int t = wave * 16 + fr;
            const bf16_t* qp = QK + (tok0 + t) * 512 + h * 64 + fq * 8;
            const bf16x8 q0 = *(const bf16x8*)qp, q1 = *(const bf16x8*)(qp + 32);
            const float m_f = MIN[chain_f * 128 + chunk], m_b = MIN[(chain_f + 1) * 128 + chunk];
            {
#pragma unroll
                for (int i = 0; i < 2; ++i) { const int c = tid + i * 512, s = c >> 3, part = c & 7;
                    *(LAS u32x4*)(Kx + s * 72 + part * 8) = kpre[i]; *(LAS u32x4*)(CfT + s * 72 + part * 8) = cfpre[i]; *(LAS u32x4*)(CbT + s * 72 + part * 8) = cbpre[i]; }
                if (tid < 16) *(LAS u32x4*)(Kx + (128 + (tid >> 3)) * 72 + (tid & 7) * 8) = npre;
                if (tid < 192) *(LAS u32x4*)(sc6 + tid * 4) = scpre;
#pragma unroll
                for (int c = 0; c < 4; ++c)
#pragma unroll
                    for (int j = 0; j < 8; ++j) VT[(q4 * 32 + c * 8 + j) * 136 + (s_st ^ (16 * q4))] = (bf16_t)vpre[c][j];
            }
            LDS_BARRIER();
            if (u + G < NB * NH * NCHUNK) M3_PREFETCH(u + G);
            {
                f32x4 sacc[9];
#pragma unroll
                for (int n = 0; n < 9; ++n) { sacc[n] = (f32x4){0.f, 0.f, 0.f, 0.f};
                    const bf16x8 kf0 = *(const LAS bf16x8*)(Kx + (n * 16 + fr) * 72 + fq * 8), kf1 = *(const LAS bf16x8*)(Kx + (n * 16 + fr) * 72 + 32 + fq * 8);
                    sacc[n] = __builtin_amdgcn_mfma_f32_16x16x32_bf16(kf0, q0, sacc[n], 0, 0, 0);
                    sacc[n] = __builtin_amdgcn_mfma_f32_16x16x32_bf16(kf1, q1, sacc[n], 0, 0, 0); }
                const float qnf = __shfl(sacc[8][0], fr), qnb = __shfl(sacc[8][1], fr);
                const float Mf = fmaxf(m_f, sc6[256 + t]), Mb = fmaxf(m_b, sc6[384 + t]);
                const float wif = __expf(m_f - Mf), wib = __expf(m_b - Mb), flf = __expf(-sc6[512 + t] - Mf), flb = __expf(-sc6[640 + t] - Mb);
                float sumf = 0.f, sumb = 0.f;
#pragma unroll
                for (int n = 0; n < 8; ++n) { const f32x4 af4 = *(const LAS f32x4*)(sc6 + n * 16 + 4 * fq), ab4 = *(const LAS f32x4*)(sc6 + 128 + n * 16 + 4 * fq);
#pragma unroll
                    for (int j = 0; j < 4; ++j) { const int s = n * 16 + 4 * fq + j; const float sv = sacc[n][j];
                        const float wf = (s <= t) ? __expf(af4[j] - Mf) : 0.f, wb = (s >= t) ? __expf(ab4[j] - Mb) : 0.f;
                        sumf += sv * wf; sumb += sv * wb; } }
                sumf += __shfl_xor(sumf, 16); sumf += __shfl_xor(sumf, 32); sumb += __shfl_xor(sumb, 16); sumb += __shfl_xor(sumb, 32);
                const float denf = 0.125f * (sumf + wif * qnf), denb = 0.125f * (sumb + wib * qnb);
                const float rf = 0.125f / fmaxf(fabsf(denf), flf), rb = 0.125f / fmaxf(fabsf(denb), flb);
                bf16x8 pfr[4], qaf[2], qab[2];
#pragma unroll
                for (int ks = 0; ks < 4; ++ks) { float pv[8];
#pragma unroll
                    for (int hh = 0; hh < 2; ++hh) { const int n = 2 * ks + hh; const f32x4 af4 = *(const LAS f32x4*)(sc6 + n * 16 + 4 * fq), ab4 = *(const LAS f32x4*)(sc6 + 128 + n * 16 + 4 * fq);
#pragma unroll
                        for (int j = 0; j < 4; ++j) { const int s = n * 16 + 4 * fq + j;
                            const float wf = (s <= t) ? __expf(af4[j] - Mf) * rf : 0.f, wb = (s >= t) ? __expf(ab4[j] - Mb) * rb : 0.f;
                            pv[hh * 4 + j] = sacc[n][j] * (wf + wb); } }
                    u32x4 w; w.x = pk2(pv[0], pv[1]); w.y = pk2(pv[2], pv[3]); w.z = pk2(pv[4], pv[5]); w.w = pk2(pv[6], pv[7]);
                    pfr[ks] = __builtin_bit_cast(bf16x8, w); }
                const float cfw = rf * wif, cbw = rb * wib;
#pragma unroll
                for (int ks = 0; ks < 2; ++ks) { const bf16x8 qv = ks ? q1 : q0; unsigned tf[4], tb[4];
#pragma unroll
                    for (int j = 0; j < 4; ++j) { const float e0 = bf2f((unsigned short)qv[2 * j]), e1 = bf2f((unsigned short)qv[2 * j + 1]); tf[j] = pk2(e0 * cfw, e1 * cfw); tb[j] = pk2(e0 * cbw, e1 * cbw); }
                    const u32x4 wfv = (u32x4){tf[0], tf[1], tf[2], tf[3]}, wbv = (u32x4){tb[0], tb[1], tb[2], tb[3]};
                    qaf[ks] = __builtin_bit_cast(bf16x8, wfv); qab[ks] = __builtin_bit_cast(bf16x8, wbv); }
                const bf16_t* op = Ob + (tok0 + t) * 512 + h * 128 + 4 * fq;
                bf16x4 ogv[8];
#pragma unroll
                for (int ne = 0; ne < 8; ++ne) ogv[ne] = *(const bf16x4*)(op + ne * 16);
                f32x4 oacc[8];
#pragma unroll
                for (int ne = 0; ne < 8; ++ne) { oacc[ne] = (f32x4){0.f, 0.f, 0.f, 0.f}; const int e = ne * 16 + fr;
#pragma unroll
                    for (int ks = 0; ks < 4; ++ks) { const int sw = 16 * ((ne >> 1) & 3); const bf16x4 lo = *(const LAS bf16x4*)(VT + e * 136 + ((ks * 32) ^ sw) + 4 * fq), hi = *(const LAS bf16x4*)(VT + e * 136 + ((ks * 32 + 16) ^ sw) + 4 * fq);
                        const bf16x8 vf = (bf16x8){lo[0], lo[1], lo[2], lo[3], hi[0], hi[1], hi[2], hi[3]};
                        oacc[ne] = __builtin_amdgcn_mfma_f32_16x16x32_bf16(vf, pfr[ks], oacc[ne], 0, 0, 0); }
#pragma unroll
                    for (int ks = 0; ks < 2; ++ks) { const bf16x8 c1 = *(const LAS bf16x8*)(CfT + e * 72 + ks * 32 + fq * 8), c2 = *(const LAS bf16x8*)(CbT + e * 72 + ks * 32 + fq * 8);
                        oacc[ne] = __builtin_amdgcn_mfma_f32_16x16x32_bf16(c1, qaf[ks], oacc[ne], 0, 0, 0);
                        oacc[ne] = __builtin_amdgcn_mfma_f32_16x16x32_bf16(c2, qab[ks], oacc[ne], 0, 0, 0); } }
                float s1 = 0.f;
#pragma unroll
                for (int ne = 0; ne < 8; ++ne) s1 += (oacc[ne][0] + oacc[ne][1]) + (oacc[ne][2] + oacc[ne][3]);
                s1 += __shfl_xor(s1, 16); s1 += __shfl_xor(s1, 32);
                const float mu = s1 * (1.0f / 128.0f); float s2 = 0.f;
#pragma unroll
                for (int ne = 0; ne < 8; ++ne) { oacc[ne] = oacc[ne] - mu; s2 += (oacc[ne][0] * oacc[ne][0] + oacc[ne][1] * oacc[ne][1]) + (oacc[ne][2] * oacc[ne][2] + oacc[ne][3] * oacc[ne][3]); }
                s2 += __shfl_xor(s2, 16); s2 += __shfl_xor(s2, 32);
                const float rstd = 1.0f / sqrtf(s2 * (1.0f / 128.0f) + LN_EPS);
                bf16_t* yp = AOUT + (tok0 + t) * KOUT + h * 128 + 4 * fq; const float* nw = a.norm_w + h * 128 + 4 * fq;
#pragma unroll
                for (int ne = 0; ne < 8; ++ne) { const f32x4 wv = *(const f32x4*)(nw + ne * 16); float y[4];
#pragma unroll
                    for (int j = 0; j < 4; ++j) { const float og = bf2f((unsigned short)ogv[ne][j]); y[j] = oacc[ne][j] * rstd * wv[j] / (1.0f + __expf(-og)); }
                    u32x2 w; w.x = pk2(y[0], y[1]); w.y = pk2(y[2], y[3]); *(u32x2*)(yp + ne * 16) = w; }
            }
        }
        LDS_BARRIER();
#undef M3_PREFETCH
    }
    xcd_barrier(xbar);
    STAMP(6);

    {
        pg8::Gemm g = pg8::std_gemm(AOUT, WOUT, MT, DM, KOUT);
        pg8::StaticOrder S; S.init(MT, DM, G, blk);
        pg8::EpiOut E{a.x, U16, mod};
        pg8::gemm_phase<pg8::EpiOut, false>(lds, g, S, E);
    }
    xcd_barrier(xbar);
    STAMP(7);

    { PHASE_IDS();
    for (int m0 = gw * 4; m0 < MT; m0 += NGW * 4) {
        f32x4 v[4][4]; LN_LOAD4_BF16(v, U16, m0);
        const float* mb = mod + (size_t)(m0 >> 14) * 6144;
        f32x4 shv[4], scv[4], lgv[4], lbv[4];
#pragma unroll
        for (int j = 0; j < 4; ++j) { shv[j] = LN_PARAM(mb + 3072, j); scv[j] = LN_PARAM(mb + 4096, j) + 1.0f; lgv[j] = LN_PARAM(a.ln1_g, j); lbv[j] = LN_PARAM(a.ln1_b, j); }
        float sq[8]; LN_STATS4(v, sq);
        if (lane < 4) { const float mu_ = lane == 0 ? sq[0] : (lane == 1 ? sq[1] : (lane == 2 ? sq[2] : sq[3])), rs_ = lane == 0 ? sq[4] : (lane == 1 ? sq[5] : (lane == 2 ? sq[6] : sq[7]));
            ST1[m0 + lane] = (f32x2){mu_, rs_}; }
#pragma unroll
        for (int r = 0; r < 4; ++r)
#pragma unroll
            for (int j = 0; j < 4; ++j) v[r][j] = (v[r][j] - sq[r]) * sq[4 + r] * lgv[j] + lbv[j];
        LN_STATS4(v, sq);
#pragma unroll
        for (int r = 0; r < 4; ++r) { bf16_t* orow = Hb + (size_t)(m0 + r) * DM + 8 * lane;
#pragma unroll
            for (int hf = 0; hf < 2; ++hf) { const f32x4 y0 = (v[r][2 * hf] - sq[r]) * sq[4 + r] * scv[2 * hf] + shv[2 * hf], y1 = (v[r][2 * hf + 1] - sq[r]) * sq[4 + r] * scv[2 * hf + 1] + shv[2 * hf + 1];
                u32x4 w; w.x = pk2(y0[0], y0[1]); w.y = pk2(y0[2], y0[3]); w.z = pk2(y1[0], y1[1]); w.w = pk2(y1[2], y1[3]); *(u32x4*)(orow + hf * 512) = w; } }
    }
    }
    xcd_barrier(xbar);
    STAMP(8);

    {
        pg8::Gemm g = pg8::std_gemm(Hb, W1, MT, FF, DM);
        pg8::StaticOrder S; S.init(MT, FF, G, blk);
        pg8::EpiFF1 E{HID, a.b_ff1};
        pg8::gemm_phase<pg8::EpiFF1, false>(lds, g, S, E);
    }
    xcd_barrier(xbar);
    STAMP(9);

    {
        pg8::Gemm g = pg8::std_gemm(HID, W2, MT, DM, FF);
        pg8::StaticOrder S; S.init(MT, DM, G, blk);
        pg8::EpiFF2 E{U16, V16, mod, ST1, a.ln1_g, a.ln1_b, a.b_ff2};
        pg8::gemm_phase<pg8::EpiFF2, false>(lds, g, S, E);
    }
    xcd_barrier(xbar);
    STAMP(10);

    { PHASE_IDS();
    for (int m0 = gw * 4; m0 < MT; m0 += NGW * 4) {
        f32x4 v[4][4]; LN_LOAD4_BF16(v, V16, m0);
        f32x4 lgv[4], lbv[4];
#pragma unroll
        for (int j = 0; j < 4; ++j) { lgv[j] = LN_PARAM(a.ln2_g, j); lbv[j] = LN_PARAM(a.ln2_b, j); }
        float sq[8]; LN_STATS4(v, sq);
#pragma unroll
        for (int r = 0; r < 4; ++r) { float* orow = a.out + (size_t)(m0 + r) * DM + 8 * lane;
#pragma unroll
            for (int j = 0; j < 4; ++j) *(f32x4*)(orow + (j >> 1) * 512 + 4 * (j & 1)) = (v[r][j] - sq[r]) * sq[4 + r] * lgv[j] + lbv[j]; }
    }
    }
    if (PROBE_PH >= 0 && blockIdx.x == 0 && threadIdx.x == 0) {
        const unsigned long long t1 = __builtin_amdgcn_s_memrealtime(); TS[11] = t1;
        const unsigned long long span = (TS[PROBE_HI] - TS[PROBE_PH]) * PROBE_MULT;
        while (__builtin_amdgcn_s_memrealtime() - t1 < span) __builtin_amdgcn_s_sleep(8);
    }
}

extern "C" void kernel_launch(void* const* d_in, const int* in_sizes, int n_in, void* d_out, int out_size, void* d_ws, size_t ws_size, hipStream_t stream) {
    static int grid = 0;
    if (grid == 0) {
        if (n_in != 16 || out_size != MT * DM || ws_size < WS_END) { fprintf(stderr, "kernel_launch: unexpected shapes (n_in %d, out %d, ws %zu)\n", n_in, out_size, ws_size); grid = -1; return; }
        int dev = 0, cus = 0, per_cu = 0;
        hipGetDevice(&dev);
        hipDeviceGetAttribute(&cus, hipDeviceAttributeMultiprocessorCount, dev);
        hipFuncSetAttribute((const void*)fwd_kernel, hipFuncAttributeMaxDynamicSharedMemorySize, LDS_BYTES);
        hipOccupancyMaxActiveBlocksPerMultiprocessor(&per_cu, (const void*)fwd_kernel, 512, LDS_BYTES);
        if (per_cu < 1) per_cu = 1;
        grid = cus * per_cu;
        if (grid > 256) grid = 256;
        (void)hipGetLastError();
    }
    if (grid < 0) return;
    Args a{};
    a.x = (const float*)d_in[0]; a.c = (const float*)d_in[1]; a.w_ada = (const float*)d_in[2]; a.b_ada = (const float*)d_in[3]; a.w_in = (const float*)d_in[4];
    a.b_gate = (const float*)d_in[5]; a.norm_w = (const float*)d_in[6]; a.w_out = (const float*)d_in[7]; a.ln1_g = (const float*)d_in[8]; a.ln1_b = (const float*)d_in[9];
    a.w_ff1 = (const float*)d_in[10]; a.b_ff1 = (const float*)d_in[11]; a.w_ff2 = (const float*)d_in[12]; a.b_ff2 = (const float*)d_in[13]; a.ln2_g = (const float*)d_in[14]; a.ln2_b = (const float*)d_in[15];
    a.out = (float*)d_out; a.ws = (unsigned char*)d_ws; a.ldw = in_sizes[4] / DM; a.pad = 0;
    (void)hipMemsetAsync((char*)d_ws + WS_BAR, 0, XCD_BAR_WORDS * 4, stream);
    void* args[] = {&a};
    hipError_t e = hipLaunchCooperativeKernel((const void*)fwd_kernel, dim3(grid), dim3(512), args, LDS_BYTES, stream);
    if (e != hipSuccess) fprintf(stderr, "cooperative launch failed: %s (grid %d)\n", hipGetErrorString(e), grid);
}
```
